# Optimizing an MI355X kernel written in HIP

```python
import math
import jax
import jax.numpy as jnp
from jax import lax
import numpy as np

D_MODEL = 2048
BATCH = 2
SEQ = 16384
DEPTH = 1
DEC_BATCH = 4
DEC_SEQ = 8192
PAST_LEN = 128

N_MEM = 256
CHUNK = 128
A_GROUPS = 8
A_WIDTH = D_MODEL
B_HEADS = 8
B_HEAD_DIM = 128
B_QK_WIDTH = B_HEADS * 2 * B_HEAD_DIM
B_V_WIDTH = B_HEADS * 2 * B_HEAD_DIM
Q_BLOCK = 128
N_BUCKETS = 32
MAX_DISTANCE = 128
C_HEADS = 4
C_HEAD_DIM = 128
C_WIDTH = C_HEADS * C_HEAD_DIM
D_FF = -(-8 * D_MODEL // (3 * 256)) * 256
N_IN = 2 * A_WIDTH + 2 * B_QK_WIDTH + B_V_WIDTH + 2 * D_MODEL
EPS = 1e-6

kernel_name = 'hybrid_gmlp_diffattn_encoder'


def _rmsnorm(x, g, eps=EPS):
    xf = x.astype(jnp.float32)
    y = xf * lax.rsqrt(jnp.mean(xf * xf, axis=-1, keepdims=True) + eps)
    return (y * g.astype(jnp.float32)).astype(x.dtype)


def _layernorm(x, g, b):
    xf = x.astype(jnp.float32)
    xc = xf - jnp.mean(xf, axis=-1, keepdims=True)
    y = xc * lax.rsqrt(jnp.mean(xc * xc, axis=-1, keepdims=True) + EPS)
    return (y * g.astype(jnp.float32) + b.astype(jnp.float32)).astype(x.dtype)


def _t5_bucket(rel):
    half = N_BUCKETS // 2
    max_exact = half // 2
    n = jnp.abs(rel)
    nf = jnp.maximum(n, 1).astype(jnp.float32)
    large = max_exact + (jnp.log(nf / max_exact) / math.log(MAX_DISTANCE / max_exact)
                         * (half - max_exact)).astype(jnp.int32)
    large = jnp.minimum(large, half - 1)
    return jnp.where(rel > 0, half, 0) + jnp.where(n < max_exact, n, large)


def _chunked_spatial_gating(u, v, ln_g, ln_b, w_s, b_s):
    bsz, seq, _ = v.shape
    u = jax.nn.gelu(u)
    v = _layernorm(jax.nn.gelu(v), ln_g, ln_b)
    vc = v.reshape(bsz, seq // CHUNK, CHUNK, A_GROUPS, A_WIDTH // A_GROUPS)
    mixed = jnp.einsum('gij,bcjgd->bcigd', w_s, vc) + jnp.transpose(b_s)[:, :, None]
    return u * mixed.reshape(bsz, seq, A_WIDTH)


def _diff_attention(q, k, v, rel_table, lam, lam_init, subln_g):
    bsz, seq, _ = q.shape
    d = B_HEAD_DIM
    n_blk = seq // Q_BLOCK
    q = q.reshape(bsz, n_blk, Q_BLOCK, B_HEADS, 2, d).transpose(4, 1, 0, 3, 2, 5)
    k = k.reshape(bsz, seq, B_HEADS, 2, d).transpose(3, 0, 2, 1, 4)
    v = v.reshape(bsz, seq, B_HEADS, 2 * d).transpose(0, 2, 1, 3)
    scale = d ** -0.5
    k_pos = jnp.arange(seq, dtype=jnp.int32)

    def one_block(args):
        q1b, q2b, start = args
        q_pos = start + jnp.arange(Q_BLOCK, dtype=jnp.int32)
        bucket = _t5_bucket(k_pos[None, :] - q_pos[:, None])
        bias = jnp.transpose(rel_table[bucket].astype(jnp.float32), (2, 0, 1))
        p1 = jax.nn.softmax(jnp.einsum('bhqd,bhkd->bhqk', q1b, k[0]).astype(jnp.float32) * scale + bias, axis=-1)
        p2 = jax.nn.softmax(jnp.einsum('bhqd,bhkd->bhqk', q2b, k[1]).astype(jnp.float32) * scale + bias, axis=-1)
        a = (p1 - lam * p2).astype(v.dtype)
        return jnp.einsum('bhqk,bhke->bhqe', a, v)

    starts = jnp.arange(n_blk, dtype=jnp.int32) * Q_BLOCK
    o = lax.map(one_block, (q[0], q[1], starts))
    o = _rmsnorm(o, subln_g, eps=1e-5) * (1.0 - lam_init)
    return o.transpose(1, 0, 3, 2, 4).reshape(bsz, seq, B_HEADS * 2 * d)


def _memory_cross_attention(x_n, mem_n, w_cq, w_ck, w_cv, w_co):
    bsz, seq, _ = x_n.shape
    q = (x_n @ w_cq).reshape(bsz, seq, C_HEADS, C_HEAD_DIM)
    k = (mem_n @ w_ck).reshape(bsz, N_MEM, C_HEADS, C_HEAD_DIM)
    v = (mem_n @ w_cv).reshape(bsz, N_MEM, C_HEADS, C_HEAD_DIM)
    s = jnp.einsum('bqhd,bkhd->bhqk', q, k).astype(jnp.float32) * (C_HEAD_DIM ** -0.5)
    p = jax.nn.softmax(s, axis=-1).astype(v.dtype)
    o = jnp.einsum('bhqk,bkhd->bqhd', p, v).reshape(bsz, seq, C_WIDTH)
    return o @ w_co


def _encoder_trunk(x, mem, rel_bias_table, norm_mix_g, w_in, ln_v_g, ln_v_b, w_spatial, b_spatial,
                   lambda_q1, lambda_k1, lambda_q2, lambda_k2, subln_g, w_proj_a, w_proj_b, w_out,
                   norm_cross_g, norm_mem_g, w_cq, w_ck, w_cv, w_co, norm_ffn_g, w_ffn_in, w_ffn_out,
                   norm_final_g):
    splits = [A_WIDTH, 2 * A_WIDTH, 2 * A_WIDTH + B_QK_WIDTH, 2 * A_WIDTH + 2 * B_QK_WIDTH,
              2 * A_WIDTH + 2 * B_QK_WIDTH + B_V_WIDTH,
              2 * A_WIDTH + 2 * B_QK_WIDTH + B_V_WIDTH + D_MODEL]
    for l in range(DEPTH):
        lam_init = 0.8 - 0.6 * math.exp(-0.3 * l)
        h = _rmsnorm(x, norm_mix_g[l])
        u, va, qb, kb, vb, g_a, g_b = jnp.split(h @ w_in[l], splits, axis=-1)
        o_a = _chunked_spatial_gating(u, va, ln_v_g[l], ln_v_b[l], w_spatial[l], b_spatial[l])
        lam = (jnp.exp(jnp.sum(lambda_q1[l].astype(jnp.float32) * lambda_k1[l].astype(jnp.float32)))
               - jnp.exp(jnp.sum(lambda_q2[l].astype(jnp.float32) * lambda_k2[l].astype(jnp.float32)))
               + lam_init)
        o_b = _diff_attention(qb, kb, vb, rel_bias_table, lam, lam_init, subln_g[l])
        merged = jax.nn.sigmoid(g_a) * (o_a @ w_proj_a[l]) + jax.nn.sigmoid(g_b) * (o_b @ w_proj_b[l])
        x = x + merged @ w_out[l]
        x = x + _memory_cross_attention(_rmsnorm(x, norm_cross_g[l]), _rmsnorm(mem, norm_mem_g[l]),
                                        w_cq[l], w_ck[l], w_cv[l], w_co[l])
        gate, up = jnp.split(_rmsnorm(x, norm_ffn_g[l]) @ w_ffn_in[l], 2, axis=-1)
        x = x + (jax.nn.silu(gate) * up) @ w_ffn_out[l]
    return _rmsnorm(x, norm_final_g)


def setup_inputs(seed: int = 0) -> dict:
    key = jax.random.key(seed)
    ks = jax.random.split(key, 32)

    def nrm(k, shape, scale):
        return jax.random.normal(k, shape, dtype=jnp.float32) * scale

    def gain(k, shape):
        return 1.0 + nrm(k, shape, 0.02)

    L = DEPTH
    return {
        'x_prompt': nrm(ks[0], (BATCH, SEQ, D_MODEL), 1.0),
        'x_sample': nrm(ks[1], (DEC_BATCH, DEC_SEQ, D_MODEL), 1.0),
        'mem_prompt': nrm(ks[2], (BATCH, N_MEM, D_MODEL), 1.0),
        'mem_sample': nrm(ks[3], (DEC_BATCH, N_MEM, D_MODEL), 1.0),
        'rel_bias_table': nrm(ks[4], (N_BUCKETS, B_HEADS), 0.5),
        'norm_mix_g': gain(ks[5], (L, D_MODEL)),
        'w_in': nrm(ks[6], (L, D_MODEL, N_IN), D_MODEL ** -0.5),
        'ln_v_g': gain(ks[7], (L, A_WIDTH)),
        'ln_v_b': nrm(ks[8], (L, A_WIDTH), 0.02),
        'w_spatial': nrm(ks[9], (L, A_GROUPS, CHUNK, CHUNK), CHUNK ** -0.5),
        'b_spatial': nrm(ks[10], (L, A_GROUPS, CHUNK), 0.02),
        'lambda_q1': nrm(ks[11], (L, B_HEAD_DIM), 0.1),
        'lambda_k1': nrm(ks[12], (L, B_HEAD_DIM), 0.1),
        'lambda_q2': nrm(ks[13], (L, B_HEAD_DIM), 0.1),
        'lambda_k2': nrm(ks[14], (L, B_HEAD_DIM), 0.1),
        'subln_g': gain(ks[15], (L, 2 * B_HEAD_DIM)),
        'w_proj_a': nrm(ks[16], (L, A_WIDTH, D_MODEL), A_WIDTH ** -0.5),
        'w_proj_b': nrm(ks[17], (L, B_V_WIDTH, D_MODEL), B_V_WIDTH ** -0.5),
        'w_out': nrm(ks[18], (L, D_MODEL, D_MODEL), D_MODEL ** -0.5),
        'norm_cross_g': gain(ks[19], (L, D_MODEL)),
        'norm_mem_g': gain(ks[20], (L, D_MODEL)),
        'w_cq': nrm(ks[21], (L, D_MODEL, C_WIDTH), D_MODEL ** -0.5),
        'w_ck': nrm(ks[22], (L, D_MODEL, C_WIDTH), D_MODEL ** -0.5),
        'w_cv': nrm(ks[23], (L, D_MODEL, C_WIDTH), D_MODEL ** -0.5),
        'w_co': nrm(ks[24], (L, C_WIDTH, D_MODEL), C_WIDTH ** -0.5),
        'norm_ffn_g': gain(ks[25], (L, D_MODEL)),
        'w_ffn_in': nrm(ks[26], (L, D_MODEL, 2 * D_FF), D_MODEL ** -0.5),
        'w_ffn_out': nrm(ks[27], (L, D_FF, D_MODEL), D_FF ** -0.5),
        'norm_final_g': gain(ks[28], (D_MODEL,)),
    }


def reference(x_prompt, x_sample, mem_prompt, mem_sample, rel_bias_table, norm_mix_g, w_in, ln_v_g, ln_v_b,
              w_spatial, b_spatial, lambda_q1, lambda_k1, lambda_q2, lambda_k2, subln_g, w_proj_a, w_proj_b,
              w_out, norm_cross_g, norm_mem_g, w_cq, w_ck, w_cv, w_co, norm_ffn_g, w_ffn_in, w_ffn_out,
              norm_final_g):
    weights = (rel_bias_table, norm_mix_g, w_in, ln_v_g, ln_v_b, w_spatial, b_spatial,
               lambda_q1, lambda_k1, lambda_q2, lambda_k2, subln_g, w_proj_a, w_proj_b, w_out,
               norm_cross_g, norm_mem_g, w_cq, w_ck, w_cv, w_co, norm_ffn_g, w_ffn_in, w_ffn_out,
               norm_final_g)
    y_prompt = _encoder_trunk(x_prompt, mem_prompt, *weights)
    y_sample = _encoder_trunk(x_sample, mem_sample, *weights)
    return (y_prompt, y_sample)
```

```cpp
#include <hip/hip_runtime.h>
#include <hip/hip_bf16.h>
#include <hip/hip_cooperative_groups.h>
#include <cstdio>
#include <cstdint>
namespace cg = cooperative_groups;

#ifndef MEGA
#define MEGA 1
#endif
#ifndef PH_MASK
#define PH_MASK 0xFFFF
#endif
#ifndef DUP_MASK
#define DUP_SEL 3
#ifndef ATT_PROBE
#define ATT_PROBE 0
#endif
#define DUP_MASK 0
#endif

typedef unsigned short u16;
using bf16x8 = __attribute__((ext_vector_type(8))) short;
using s16x4  = __attribute__((ext_vector_type(4))) short;
using f32x16 = __attribute__((ext_vector_type(16))) float;
using f32x4  = __attribute__((ext_vector_type(4))) float;
using u32x4  = __attribute__((ext_vector_type(4))) unsigned;
using u32x2  = __attribute__((ext_vector_type(2))) unsigned;

#define DI __device__ __forceinline__
#define SBAR() __builtin_amdgcn_sched_barrier(0)
#define VMWAIT0() __builtin_amdgcn_s_waitcnt(0x0F70)

constexpr int DM = 2048;
constexpr int GT = 16384;
constexpr int NGROUP = 4;
constexpr int NIN = 14336;
constexpr int DFF = 5632;
constexpr int NMEMROWS = 1536;
constexpr int NT_THREADS = 512;
constexpr float LOG2E = 1.4426950408889634f;

constexpr size_t SEGSZ   = (size_t)GT * DM * 2;
constexpr size_t O_WT_IN = 0;
constexpr size_t O_WT_PA = O_WT_IN + (size_t)NIN * DM * 2;
constexpr size_t O_WT_PB = O_WT_PA + (size_t)DM * DM * 2;
constexpr size_t O_WT_OUT= O_WT_PB + (size_t)DM * DM * 2;
constexpr size_t O_WT_CQ = O_WT_OUT + (size_t)DM * DM * 2;
constexpr size_t O_WT_CKV= O_WT_CQ + (size_t)512 * DM * 2;
constexpr size_t O_WT_CO = O_WT_CKV + (size_t)1024 * DM * 2;
constexpr size_t O_WT_FI = O_WT_CO + (size_t)DM * 512 * 2;
constexpr size_t O_WT_FO = O_WT_FI + (size_t)2 * DFF * DM * 2;
constexpr size_t O_MEMB  = O_WT_FO + (size_t)DM * DFF * 2;
constexpr size_t O_MEMRS = O_MEMB + (size_t)NMEMROWS * DM * 2;
constexpr size_t O_MEMKV = O_MEMRS + 8192;
constexpr size_t O_BTAB  = O_MEMKV + (size_t)NMEMROWS * 1024 * 2;
constexpr size_t O_RSTD  = O_BTAB + 16384;
constexpr size_t O_XB    = O_RSTD + (size_t)GT * 4;
constexpr size_t O_SEG   = O_XB + SEGSZ;
constexpr size_t O_OP    = O_SEG + 7 * SEGSZ;
constexpr size_t O_LNST  = O_OP + 2 * SEGSZ;
constexpr size_t O_SS2   = O_LNST + (size_t)GT * 8;
constexpr size_t O_SS3   = O_SS2 + (size_t)GT * 4;
constexpr size_t O_BAR   = O_SS3 + (size_t)GT * 4;
constexpr size_t O_END   = O_BAR + 16384;

struct Params {
  const float *x_prompt, *x_sample, *mem_prompt, *mem_sample, *rel_table, *norm_mix_g, *w_in, *ln_v_g, *ln_v_b,
      *w_spatial, *b_spatial, *lq1, *lk1, *lq2, *lk2, *subln_g, *w_pa, *w_pb, *w_out, *norm_cross_g, *norm_mem_g,
      *w_cq, *w_ck, *w_cv, *w_co, *norm_ffn_g, *w_fi, *w_fo, *norm_final_g;
  float* out;
  char* ws;
};

DI int otid() { int t = threadIdx.x; asm volatile("" : "+v"(t)); return t; }
DI int crow(int r, int hi) { return (r & 3) + 8 * (r >> 2) + 4 * hi; }
DI unsigned cvtpk(float lo, float hi) { unsigned r; asm volatile("v_cvt_pk_bf16_f32 %0, %1, %2" : "=v"(r) : "v"(lo), "v"(hi)); return r; }
DI u16 f2bf(float x) { return (u16)(cvtpk(x, x) & 0xffffu); }
DI float bf2f(u16 v) { return __uint_as_float(((unsigned)v) << 16); }
DI float bflo(unsigned w) { return __uint_as_float(w << 16); }
DI float bfhi(unsigned w) { return __uint_as_float(w & 0xffff0000u); }
DI bf16x8 ld8(const u16* p) { return *reinterpret_cast<const bf16x8*>(p); }
DI float gelu_tanh(float x) {
  float y = 0.7978845608028654f * (x + 0.044715f * x * x * x);
  float t = __builtin_amdgcn_exp2f(y * (2.f * LOG2E));
  float th = 1.f - 2.f * __builtin_amdgcn_rcpf(t + 1.f);
  return 0.5f * x * (1.f + th);
}
DI float sigmoidf_(float x) { return 1.f - __builtin_amdgcn_rcpf(1.f + __builtin_amdgcn_exp2f(x * LOG2E)); }
DI float wave_sum(float v) {
#pragma unroll
  for (int o = 32; o > 0; o >>= 1) v += __shfl_xor(v, o, 64);
  return v;
}
DI int t5_bucket(int rel) {
  int n = rel < 0 ? -rel : rel;
  int b;
  if (n < 8) b = n;
  else if (n >= 128) b = 15;
  else { int l2 = 31 - __clz(n * n); b = 8 + (l2 - 6); if (b > 15) b = 15; }
  return b + (rel > 0 ? 16 : 0);
}

DI bool tile_map(int vb, int nrt, int nct, int CR, int CC, int& rt, int& ct) {
  if (CR == 0) { if (vb >= nrt * nct) return false; rt = vb % nrt; ct = vb / nrt; return true; }
  const int it = vb >> 8, b = vb & 255, xcd = b & 7, j = b >> 3;
  const int c = it * 8 + xcd, ncr = nrt / CR, nchunks = ncr * (nct / CC);
  if (c >= nchunks) return false;
  rt = (c % ncr) * CR + (j % CR); ct = (c / ncr) * CC + (j / CR);
  return true;
}
DI int tile_vb_end(int nrt, int nct, int CR) { return CR == 0 ? nrt * nct : ((nrt * nct / 32 + 7) / 8) * 256; }

constexpr int LROW = 144;
constexpr int LTILE = 256 * LROW;
constexpr int LDS_BYTES = 4 * LTILE;

DI void gemm_loop(f32x16 (&acc)[4][2], const u16* __restrict__ A, long lda, const u16* __restrict__ Bt, long ldb, int K, char* lds) {
  const int tid = otid(), lane = tid & 63, wid = tid >> 6, r32 = lane & 31, hi = lane >> 5, wm = wid >> 2, wn = wid & 3;
  const u16* ga = A + (long)(tid >> 3) * lda + (tid & 7) * 8;
  const u16* gb = Bt + (long)(tid >> 3) * ldb + (tid & 7) * 8;
  const int soff = (tid >> 3) * LROW + (tid & 7) * 16;
  bf16x8 ra[4], rb[4];
#pragma unroll
  for (int i = 0; i < 4; ++i) { ra[i] = ld8(ga + (long)i * 64 * lda); rb[i] = ld8(gb + (long)i * 64 * ldb); }
  __syncthreads();
#pragma unroll
  for (int i = 0; i < 4; ++i) {
    *reinterpret_cast<bf16x8*>(lds + soff + i * 64 * LROW) = ra[i];
    *reinterpret_cast<bf16x8*>(lds + LTILE + soff + i * 64 * LROW) = rb[i];
  }
  __syncthreads();
  const int nt = K >> 6;
  const int aoff = (wm * 128 + r32) * LROW + hi * 16, boff = LTILE + (wn * 64 + r32) * LROW + hi * 16;
  for (int t = 0; t < nt; ++t) {
    const char* cur = lds + (t & 1) * 2 * LTILE;
    if (t + 1 < nt) {
      const int k0 = (t + 1) * 64;
#pragma unroll
      for (int i = 0; i < 4; ++i) { ra[i] = ld8(ga + (long)i * 64 * lda + k0); rb[i] = ld8(gb + (long)i * 64 * ldb + k0); }
    }
#pragma unroll
    for (int ks = 0; ks < 4; ++ks) {
      bf16x8 a[4], b[2];
#pragma unroll
      for (int mi = 0; mi < 4; ++mi) a[mi] = *reinterpret_cast<const bf16x8*>(cur + aoff + mi * 32 * LROW + ks * 32);
#pragma unroll
      for (int ni = 0; ni < 2; ++ni) b[ni] = *reinterpret_cast<const bf16x8*>(cur + boff + ni * 32 * LROW + ks * 32);
#pragma unroll
      for (int mi = 0; mi < 4; ++mi)
#pragma unroll
        for (int ni = 0; ni < 2; ++ni) acc[mi][ni] = __builtin_amdgcn_mfma_f32_32x32x16_bf16(a[mi], b[ni], acc[mi][ni], 0, 0, 0);
    }
    if (t + 1 < nt) {
      char* nxt = lds + ((t + 1) & 1) * 2 * LTILE;
#pragma unroll
      for (int i = 0; i < 4; ++i) {
        *reinterpret_cast<bf16x8*>(nxt + soff + i * 64 * LROW) = ra[i];
        *reinterpret_cast<bf16x8*>(nxt + LTILE + soff + i * 64 * LROW) = rb[i];
      }
    }
    __syncthreads();
  }
}
DI void acc_zero(f32x16 (&acc)[4][2]) {
#pragma unroll
  for (int mi = 0; mi < 4; ++mi)
#pragma unroll
    for (int ni = 0; ni < 2; ++ni)
#pragma unroll
      for (int i = 0; i < 16; ++i) acc[mi][ni][i] = 0.f;
}
#define EPI_FOR(...)                                                                               \
  {                                                                                                \
    int tid_ = otid();                                                                              \
    const int lane_ = tid_ & 63, wid_ = tid_ >> 6, r32_ = lane_ & 31, hi_ = lane_ >> 5;             \
    const int wm_ = wid_ >> 2, wn_ = wid_ & 3;                                                     \
    _Pragma("unroll") for (int mi = 0; mi < 4; ++mi) _Pragma("unroll") for (int i = 0; i < 16; ++i) { \
      const int lrow = wm_ * 128 + mi * 32 + crow(i, hi_);                                         \
      _Pragma("unroll") for (int ni = 0; ni < 2; ++ni) {                                           \
        const int lcol = wn_ * 64 + ni * 32 + r32_;                                                \
        const float v = acc[mi][ni][i];                                                            \
        __VA_ARGS__                                                                                \
      }                                                                                            \
    }                                                                                              \
  }

namespace pg8 {
#define PG8_LAS __attribute__((address_space(3)))
constexpr int BM = 256, BK = 64, HALF = 128, HTB = HALF * BK * 2, STAGE_BYTES = 8 * HTB, NXCD = 8, WGM = 8;
DI int lds_byte(int r, int c) { const int st = (r >> 4) * 2 + (c >> 5), rr = r & 15, cc = c & 31, ob = rr * 64 + cc * 2; return st * 1024 + (ob ^ (((ob >> 9) & 1) << 5)); }
DI void stage_rc(int b, int& R, int& C) { const int st = b / 1024, sb = b % 1024, swz = sb ^ (((sb >> 9) & 1) << 5); R = (st >> 1) * 16 + swz / 64; C = (st & 1) * 32 + (swz % 64) / 2; }
DI int perm32(int rho) { const int n = rho >> 4, i = rho & 15; return 8 * (i >> 2) + 4 * n + (i & 3); }
struct Unit { int pm, pn; };
struct Gemm { const u16* A; const u16* Bt; int M, N, K; };
struct StaticOrder {
  int nM, nN, nwg, G, c;
  DI void init(int M, int N, int G_, int c_) { nM = M / BM; nN = N / BM; nwg = nM * nN; G = G_; c = c_; }
  DI bool next(int i, Unit& u) const {
    const long L = (long)i * G + c; if (L >= nwg) return false;
    int wgid = (int)L; { const int q = nwg / NXCD, r = nwg % NXCD, xcd = wgid % NXCD, off = wgid / NXCD; wgid = (xcd < r ? xcd * (q + 1) : r * (q + 1) + (xcd - r) * q) + off; }
    const int nig = WGM * nN, gid = wgid / nig, fm = gid * WGM, gsz = (nM - fm) < WGM ? (nM - fm) : WGM;
    u.pm = fm + ((wgid % nig) % gsz); u.pn = (wgid % nig) / gsz; return true;
  }
};
template <class Epi>
DI void gemm_phase(PG8_LAS unsigned char* lds, const Gemm g, const StaticOrder& S, const Epi& E) {
  const int tid = otid(), wid = __builtin_amdgcn_readfirstlane(tid >> 6), lane = tid & 63, wr = wid >> 2, wc = wid & 3, fr = lane & 15, fq = lane >> 4;
  const int K = g.K, nt = K / BK;
  unsigned voffA[2], voffB[2];
#pragma unroll
  for (int i = 0; i < 2; ++i) { int R, C; stage_rc(tid * 16 + i * 8192, R, C); const int Rb = (R & ~31) + perm32(R & 31);
    voffA[i] = (unsigned)(R * K + C) * 2u; voffB[i] = (unsigned)(Rb * K + C) * 2u; }
  const size_t kstep = (size_t)(BK * 2);
  const size_t hstep = (size_t)HALF * K * 2;
  const size_t tstep = 2 * hstep;
  const unsigned ldsw = (unsigned)wid * 1024u;
  const int aoff = lds_byte(wr * 64 + fr, fq * 8), boff = lds_byte(wc * 32 + fr, fq * 8);
#define PG8_SA(b, h) (((b) * 2 + (h)) * HTB)
#define PG8_SB(b, h) ((4 + (b) * 2 + (h)) * HTB)
#define PG8_STAGE(bufoff, gbase, voff) do { _Pragma("unroll") for (int _i = 0; _i < 2; ++_i) \
    __builtin_amdgcn_global_load_lds((const unsigned*)((const char*)(gbase) + (voff)[_i]), (PG8_LAS unsigned*)(lds + (bufoff) + ldsw + _i * 8192), 16, 0, 0); } while (0)
#define PG8_LDA(dst, b, h) do { _Pragma("unroll") for (int m = 0; m < 4; ++m) _Pragma("unroll") for (int k = 0; k < 2; ++k) dst[m][k] = *(const PG8_LAS bf16x8*)(lds + PG8_SA(b, h) + aoff + m * 2048 + k * 1024); } while (0)
#define PG8_LDB(dst, b, h) do { _Pragma("unroll") for (int n = 0; n < 2; ++n) _Pragma("unroll") for (int k = 0; k < 2; ++k) dst[n][k] = *(const PG8_LAS bf16x8*)(lds + PG8_SB(b, h) + boff + n * 2048 + k * 1024); } while (0)
#define PG8_MMA(ai, bj, At, Bt) do { __builtin_amdgcn_s_setprio(1); _Pragma("unroll") for (int m = 0; m < 4; ++m) _Pragma("unroll") for (int n = 0; n < 2; ++n) _Pragma("unroll") for (int k = 0; k < 2; ++k) \
    acc[ai][bj][m][n] = __builtin_amdgcn_mfma_f32_16x16x32_bf16(Bt[n][k], At[m][k], acc[ai][bj][m][n], 0, 0, 0); __builtin_amdgcn_s_setprio(0); } while (0)
#define PG8_WAIT_V(n) asm volatile("s_waitcnt vmcnt(" #n ")" ::: "memory")
#define PG8_WAIT_L(n) asm volatile("s_waitcnt lgkmcnt(" #n ")" ::: "memory")
#define PG8_BAR __builtin_amdgcn_s_barrier()
#define PG8_SCHED __builtin_amdgcn_sched_barrier(0)
  Unit cur, nxt; int ui = 0;
  if (!S.next(0, cur)) return;
  f32x4 acc[2][2][4][2];
#pragma unroll
  for (int a = 0; a < 2; ++a)
#pragma unroll
    for (int b = 0; b < 2; ++b)
#pragma unroll
      for (int m = 0; m < 4; ++m)
#pragma unroll
        for (int n = 0; n < 2; ++n) acc[a][b][m][n] = (f32x4){0.f, 0.f, 0.f, 0.f};
  bf16x8 At[4][2], B0[2][2], B1[2][2];
  const char* cA = (const char*)g.A + (size_t)cur.pm * tstep; const char* cB = (const char*)g.Bt + (size_t)cur.pn * tstep;
  PG8_STAGE(PG8_SB(0, 0), cB, voffB); PG8_STAGE(PG8_SA(0, 0), cA, voffA); PG8_STAGE(PG8_SB(0, 1), cB + hstep, voffB); PG8_STAGE(PG8_SA(0, 1), cA + hstep, voffA);
  if (wr == 1) PG8_BAR;
  PG8_WAIT_V(4); PG8_BAR;
  PG8_STAGE(PG8_SB(1, 0), cB + kstep, voffB); PG8_STAGE(PG8_SA(1, 0), cA + kstep, voffA); PG8_STAGE(PG8_SB(1, 1), cB + hstep + kstep, voffB);
  PG8_WAIT_V(6); PG8_BAR;
  for (;;) {
    const bool has_next = S.next(ui + 1, nxt);
    const char* nA = has_next ? (const char*)g.A + (size_t)nxt.pm * tstep : cA; const char* nB = has_next ? (const char*)g.Bt + (size_t)nxt.pn * tstep : cB;
    for (int t = 0; t < nt; t += 2) {
      const bool last = (t == nt - 2);
      const char* a1 = cA + (size_t)(t + 1) * kstep;
      const char* a2 = last ? nA : cA + (size_t)(t + 2) * kstep; const char* b2 = last ? nB : cB + (size_t)(t + 2) * kstep;
      const char* a3 = a2 + kstep; const char* b3 = b2 + kstep;
      PG8_LDB(B0, 0, 0); PG8_SCHED; PG8_LDA(At, 0, 0); PG8_STAGE(PG8_SA(1, 1), a1 + hstep, voffA);
      PG8_WAIT_L(8); PG8_BAR; PG8_WAIT_L(0); PG8_MMA(0, 0, At, B0); PG8_BAR; PG8_SCHED;
      PG8_LDB(B1, 0, 1); PG8_STAGE(PG8_SB(0, 0), b2, voffB);
      PG8_BAR; PG8_WAIT_L(0); PG8_MMA(0, 1, At, B1); PG8_BAR;
      PG8_LDA(At, 0, 1); PG8_STAGE(PG8_SA(0, 0), a2, voffA);
      PG8_BAR; PG8_WAIT_L(0); PG8_MMA(1, 0, At, B0); PG8_BAR; PG8_SCHED;
      PG8_STAGE(PG8_SB(0, 1), b2 + hstep, voffB);
      PG8_WAIT_V(6); PG8_BAR; PG8_MMA(1, 1, At, B1); PG8_BAR;
      PG8_LDB(B0, 1, 0); PG8_SCHED; PG8_LDA(At, 1, 0); PG8_STAGE(PG8_SA(0, 1), a2 + hstep, voffA);
      PG8_WAIT_L(8); PG8_BAR; PG8_WAIT_L(0); PG8_MMA(0, 0, At, B0); PG8_BAR; PG8_SCHED;
      PG8_LDB(B1, 1, 1); PG8_STAGE(PG8_SB(1, 0), b3, voffB);
      PG8_BAR; PG8_WAIT_L(0); PG8_MMA(0, 1, At, B1); PG8_BAR;
      PG8_LDA(At, 1, 1); PG8_STAGE(PG8_SA(1, 0), a3, voffA);
      PG8_BAR; PG8_WAIT_L(0); PG8_MMA(1, 0, At, B0); PG8_BAR; PG8_SCHED;
      PG8_STAGE(PG8_SB(1, 1), b3 + hstep, voffB);
      PG8_WAIT_V(6); PG8_BAR; PG8_MMA(1, 1, At, B1); PG8_BAR;
    }
    E(acc, cur, wr, wc, fr, fq);
    if (!has_next) break;
#pragma unroll
    for (int a = 0; a < 2; ++a)
#pragma unroll
      for (int b = 0; b < 2; ++b)
#pragma unroll
        for (int m = 0; m < 4; ++m)
#pragma unroll
          for (int n = 0; n < 2; ++n) acc[a][b][m][n] = (f32x4){0.f, 0.f, 0.f, 0.f};
    cur = nxt; cA = nA; cB = nB; ++ui;
  }
  PG8_WAIT_V(0);
  if (wr == 0) PG8_BAR;
  PG8_BAR;
#undef PG8_SA
#undef PG8_SB
#undef PG8_STAGE
#undef PG8_LDA
#undef PG8_LDB
#undef PG8_MMA
#undef PG8_WAIT_V
#undef PG8_WAIT_L
#undef PG8_BAR
#undef PG8_SCHED
}
}
using pg8::Unit;
typedef const f32x4 (&AccRef)[2][2][4][2];
constexpr long SEGE_ = (long)GT * DM;
DI u32x4 pack8(f32x4 a, f32x4 b) { u32x4 w = {cvtpk(a[0], a[1]), cvtpk(a[2], a[3]), cvtpk(b[0], b[1]), cvtpk(b[2], b[3])}; return w; }
DI f32x4 bf4lo(u32x4 w) { f32x4 r = {bflo(w[0]), bfhi(w[0]), bflo(w[1]), bfhi(w[1])}; return r; }
DI f32x4 bf4hi(u32x4 w) { f32x4 r = {bflo(w[2]), bfhi(w[2]), bflo(w[3]), bfhi(w[3])}; return r; }
#define EPI8_FOR(...)                                                                                     \
  _Pragma("unroll") for (int ai = 0; ai < 2; ++ai) _Pragma("unroll") for (int m = 0; m < 4; ++m) {        \
    const int ROW = u.pm * 256 + ai * 128 + wr * 64 + m * 16 + fr;                                        \
    _Pragma("unroll") for (int bj = 0; bj < 2; ++bj) {                                                    \
      const int LCOL = bj * 128 + wc * 32 + 8 * fq;                                                       \
      f32x4 v0 = acc[ai][bj][m][0], v1 = acc[ai][bj][m][1];                                               \
      __VA_ARGS__                                                                                         \
    }                                                                                                     \
  }
struct EpiInproj {
  u16* seg; const float* rstd; float* lnacc; unsigned* kmax; int slen;
  DI void operator()(AccRef acc, const Unit& u, int wr, int wc, int fr, int fq) const {
    const int sg = u.pn >> 3; u16* base = seg + sg * SEGE_ + (u.pn & 7) * 256;
    float rs8[2][4];
#pragma unroll
    for (int ai = 0; ai < 2; ++ai)
#pragma unroll
      for (int m = 0; m < 4; ++m) rs8[ai][m] = 1.f;
    if (sg == 0) {
      EPI8_FOR({ const float rs = rs8[ai][m];
        _Pragma("unroll") for (int e = 0; e < 4; ++e) { v0[e] = gelu_tanh(v0[e] * rs); v1[e] = gelu_tanh(v1[e] * rs); }
        *reinterpret_cast<u32x4*>(base + (long)ROW * DM + LCOL) = pack8(v0, v1); })
    } else if (sg == 1) {
#pragma unroll
      for (int ai = 0; ai < 2; ++ai)
#pragma unroll
        for (int m = 0; m < 4; ++m) {
          const int ROW = u.pm * 256 + ai * 128 + wr * 64 + m * 16 + fr; const float rs = rs8[ai][m]; float s1 = 0.f, s2 = 0.f;
#pragma unroll
          for (int bj = 0; bj < 2; ++bj) {
            f32x4 v0 = acc[ai][bj][m][0], v1 = acc[ai][bj][m][1];
#pragma unroll
            for (int e = 0; e < 4; ++e) { v0[e] = gelu_tanh(v0[e] * rs); v1[e] = gelu_tanh(v1[e] * rs); }
            const u32x4 w = pack8(v0, v1);
            *reinterpret_cast<u32x4*>(base + (long)ROW * DM + bj * 128 + wc * 32 + 8 * fq) = w;
            const f32x4 r0 = bf4lo(w), r1 = bf4hi(w);
#pragma unroll
            for (int e = 0; e < 4; ++e) { s1 += r0[e] + r1[e]; s2 = fmaf(r0[e], r0[e], fmaf(r1[e], r1[e], s2)); }
          }
          s1 += __shfl_xor(s1, 16, 64); s1 += __shfl_xor(s1, 32, 64); s2 += __shfl_xor(s2, 16, 64); s2 += __shfl_xor(s2, 32, 64);
          if (fq == 0) { atomicAdd(lnacc + 2 * ROW, s1); atomicAdd(lnacc + 2 * ROW + 1, s2); }
        }
    } else if (sg == 3) {
      float mx0 = 0.f, mx1 = 0.f;
#pragma unroll
      for (int ai = 0; ai < 2; ++ai)
#pragma unroll
        for (int m = 0; m < 4; ++m) {
          const int ROW = u.pm * 256 + ai * 128 + wr * 64 + m * 16 + fr; const float rs = rs8[ai][m];
#pragma unroll
          for (int bj = 0; bj < 2; ++bj) {
            const u32x4 w = pack8(acc[ai][bj][m][0] * rs, acc[ai][bj][m][1] * rs);
            *reinterpret_cast<u32x4*>(base + (long)ROW * DM + bj * 128 + wc * 32 + 8 * fq) = w;
            const f32x4 r0 = bf4lo(w), r1 = bf4hi(w); float pp = 0.f;
#pragma unroll
            for (int e = 0; e < 4; ++e) pp = fmaf(r0[e], r0[e], fmaf(r1[e], r1[e], pp));
            pp += __shfl_xor(pp, 16, 64); pp += __shfl_xor(pp, 32, 64);
            if (bj == 0) mx0 = fmaxf(mx0, pp); else mx1 = fmaxf(mx1, pp);
          }
        }
#pragma unroll
      for (int o = 1; o < 16; o <<= 1) { mx0 = fmaxf(mx0, __shfl_xor(mx0, o, 64)); mx1 = fmaxf(mx1, __shfl_xor(mx1, o, 64)); }
      if ((threadIdx.x & 63) == 0) {
        const int sq = (u.pm * 256 >= slen) ? 1 : 0, hm = (u.pn & 7) * 2;
        atomicMax(kmax + sq * 16 + hm, __float_as_uint(4.f * mx0)); atomicMax(kmax + sq * 16 + hm + 1, __float_as_uint(4.f * mx1));
      }
    } else if (sg < 5) {
      EPI8_FOR({ const float rs = rs8[ai][m]; *reinterpret_cast<u32x4*>(base + (long)ROW * DM + LCOL) = pack8(v0 * rs, v1 * rs); })
    } else {
      EPI8_FOR({ const float rs = rs8[ai][m];
        _Pragma("unroll") for (int e = 0; e < 4; ++e) { v0[e] = sigmoidf_(v0[e] * rs); v1[e] = sigmoidf_(v1[e] * rs); }
        *reinterpret_cast<u32x4*>(base + (long)ROW * DM + LCOL) = pack8(v0, v1); })
    }
  }
};
struct EpiScaleBf16 {
  u16* dst; int ldc; const float* rstd; const float* ss;
  DI void operator()(AccRef acc, const Unit& u, int wr, int wc, int fr, int fq) const {
    float rs8[2][4];
#pragma unroll
    for (int ai = 0; ai < 2; ++ai)
#pragma unroll
      for (int m = 0; m < 4; ++m) { const int R_ = u.pm * 256 + ai * 128 + wr * 64 + m * 16 + fr; rs8[ai][m] = ss ? ss[R_] : rstd[R_]; }
    VMWAIT0(); SBAR();
    EPI8_FOR({ const float rs = ss ? rsqrtf(rs8[ai][m] * (1.f / 2048.f) + 1e-6f) : rs8[ai][m]; *reinterpret_cast<u32x4*>(dst + (long)ROW * ldc + u.pn * 256 + LCOL) = pack8(v0 * rs, v1 * rs); })
  }
};
struct EpiMerge1 {
  float* T; const u16* GA;
  DI void operator()(AccRef acc, const Unit& u, int wr, int wc, int fr, int fq) const {
#pragma unroll
    for (int ai = 0; ai < 2; ++ai) {
      u32x4 gw[4][2];
#pragma unroll
      for (int m = 0; m < 4; ++m)
#pragma unroll
        for (int bj = 0; bj < 2; ++bj) gw[m][bj] = *reinterpret_cast<const u32x4*>(GA + (long)(u.pm * 256 + ai * 128 + wr * 64 + m * 16 + fr) * DM + u.pn * 256 + bj * 128 + wc * 32 + 8 * fq);
      VMWAIT0(); SBAR();
#pragma unroll
      for (int m = 0; m < 4; ++m)
#pragma unroll
        for (int bj = 0; bj < 2; ++bj) { const long idx = (long)(u.pm * 256 + ai * 128 + wr * 64 + m * 16 + fr) * DM + u.pn * 256 + bj * 128 + wc * 32 + 8 * fq;
          *reinterpret_cast<f32x4*>(T + idx) = acc[ai][bj][m][0] * bf4lo(gw[m][bj]); *reinterpret_cast<f32x4*>(T + idx + 4) = acc[ai][bj][m][1] * bf4hi(gw[m][bj]); }
      SBAR();
    }
  }
};
struct EpiMerge2 {
  const float* T; const u16* GB; u16* MG;
  DI void operator()(AccRef acc, const Unit& u, int wr, int wc, int fr, int fq) const {
#pragma unroll
    for (int ai = 0; ai < 2; ++ai)
#pragma unroll
      for (int mh = 0; mh < 2; ++mh) {
        u32x4 gw[2][2]; f32x4 t0[2][2], t1[2][2];
#pragma unroll
        for (int mm = 0; mm < 2; ++mm)
#pragma unroll
          for (int bj = 0; bj < 2; ++bj) { const long idx = (long)(u.pm * 256 + ai * 128 + wr * 64 + (mh * 2 + mm) * 16 + fr) * DM + u.pn * 256 + bj * 128 + wc * 32 + 8 * fq;
            gw[mm][bj] = *reinterpret_cast<const u32x4*>(GB + idx); t0[mm][bj] = *reinterpret_cast<const f32x4*>(T + idx); t1[mm][bj] = *reinterpret_cast<const f32x4*>(T + idx + 4); }
        VMWAIT0(); SBAR();
#pragma unroll
        for (int mm = 0; mm < 2; ++mm)
#pragma unroll
          for (int bj = 0; bj < 2; ++bj) { const int m = mh * 2 + mm; const long idx = (long)(u.pm * 256 + ai * 128 + wr * 64 + m * 16 + fr) * DM + u.pn * 256 + bj * 128 + wc * 32 + 8 * fq;
            *reinterpret_cast<u32x4*>(MG + idx) = pack8(t0[mm][bj] + acc[ai][bj][m][0] * bf4lo(gw[mm][bj]), t1[mm][bj] + acc[ai][bj][m][1] * bf4hi(gw[mm][bj])); }
        SBAR();
      }
  }
};
struct EpiResid {
  const float* xin; float* xout;
  DI void operator()(AccRef acc, const Unit& u, int wr, int wc, int fr, int fq) const {
#pragma unroll
    for (int ai = 0; ai < 2; ++ai) {
      f32x4 t0[4][2], t1[4][2];
#pragma unroll
      for (int m = 0; m < 4; ++m)
#pragma unroll
        for (int bj = 0; bj < 2; ++bj) { const long idx = (long)(u.pm * 256 + ai * 128 + wr * 64 + m * 16 + fr) * DM + u.pn * 256 + bj * 128 + wc * 32 + 8 * fq;
          t0[m][bj] = *reinterpret_cast<const f32x4*>(xin + idx); t1[m][bj] = *reinterpret_cast<const f32x4*>(xin + idx + 4); }
      VMWAIT0(); SBAR();
#pragma unroll
      for (int m = 0; m < 4; ++m)
#pragma unroll
        for (int bj = 0; bj < 2; ++bj) { const long idx = (long)(u.pm * 256 + ai * 128 + wr * 64 + m * 16 + fr) * DM + u.pn * 256 + bj * 128 + wc * 32 + 8 * fq;
          *reinterpret_cast<f32x4*>(xout + idx) = t0[m][bj] + acc[ai][bj][m][0]; *reinterpret_cast<f32x4*>(xout + idx + 4) = t1[m][bj] + acc[ai][bj][m][1]; }
      SBAR();
    }
  }
};
struct EpiResidNorm {
  const float* xin; float* xout; u16* xb; float* ss;
  DI void operator()(AccRef acc, const Unit& u, int wr, int wc, int fr, int fq) const {
#pragma unroll
    for (int ai = 0; ai < 2; ++ai) {
      f32x4 t0[4][2], t1[4][2];
#pragma unroll
      for (int m = 0; m < 4; ++m)
#pragma unroll
        for (int bj = 0; bj < 2; ++bj) { const long idx = (long)(u.pm * 256 + ai * 128 + wr * 64 + m * 16 + fr) * DM + u.pn * 256 + bj * 128 + wc * 32 + 8 * fq;
          t0[m][bj] = *reinterpret_cast<const f32x4*>(xin + idx); t1[m][bj] = *reinterpret_cast<const f32x4*>(xin + idx + 4); }
      VMWAIT0(); SBAR();
#pragma unroll
      for (int m = 0; m < 4; ++m) {
        const int ROW = u.pm * 256 + ai * 128 + wr * 64 + m * 16 + fr; float part = 0.f;
#pragma unroll
        for (int bj = 0; bj < 2; ++bj) {
          const long idx = (long)ROW * DM + u.pn * 256 + bj * 128 + wc * 32 + 8 * fq;
          const f32x4 y0 = t0[m][bj] + acc[ai][bj][m][0], y1 = t1[m][bj] + acc[ai][bj][m][1];
          *reinterpret_cast<f32x4*>(xout + idx) = y0; *reinterpret_cast<f32x4*>(xout + idx + 4) = y1;
          *reinterpret_cast<u32x4*>(xb + idx) = pack8(y0, y1);
#pragma unroll
          for (int e = 0; e < 4; ++e) part = fmaf(y0[e], y0[e], fmaf(y1[e], y1[e], part));
        }
        part += __shfl_xor(part, 16, 64); part += __shfl_xor(part, 32, 64);
        if (fq == 0) atomicAdd(ss + ROW, part);
      }
      SBAR();
    }
  }
};
struct EpiSwiglu {
  u16* hid; const float* ss;
  DI void operator()(AccRef acc, const Unit& u, int wr, int wc, int fr, int fq) const {
    float rs8[2][4];
#pragma unroll
    for (int ai = 0; ai < 2; ++ai)
#pragma unroll
      for (int m = 0; m < 4; ++m) rs8[ai][m] = ss[u.pm * 256 + ai * 128 + wr * 64 + m * 16 + fr];
    VMWAIT0(); SBAR();
#pragma unroll
    for (int ai = 0; ai < 2; ++ai)
#pragma unroll
      for (int m = 0; m < 4; ++m) {
        const int ROW = u.pm * 256 + ai * 128 + wr * 64 + m * 16 + fr; const float rs = rsqrtf(rs8[ai][m] * (1.f / 2048.f) + 1e-6f);
        f32x4 g0 = acc[ai][0][m][0] * rs, g1 = acc[ai][0][m][1] * rs, u0 = acc[ai][1][m][0] * rs, u1 = acc[ai][1][m][1] * rs;
#pragma unroll
        for (int e = 0; e < 4; ++e) { g0[e] = g0[e] * sigmoidf_(g0[e]) * u0[e]; g1[e] = g1[e] * sigmoidf_(g1[e]) * u1[e]; }
        *reinterpret_cast<u32x4*>(hid + (long)ROW * DFF + u.pn * 128 + wc * 32 + 8 * fq) = pack8(g0, g1);
      }
  }
};
template <class Epi> DI void run_gemm(char* lds, const u16* A, const u16* Bt, int M, int N, int K, const Epi& E) {
  extern __shared__ __attribute__((aligned(16))) unsigned char gemm_shm[];
  (void)lds;
  pg8::Gemm G{A, Bt, M, N, K}; pg8::StaticOrder S; S.init(M, N, (int)gridDim.x, (int)blockIdx.x);
  pg8::gemm_phase<Epi>((PG8_LAS unsigned char*)gemm_shm, G, S, E);
}

struct ConvJob { const float* src; const float* g; u16* dst; int N, K, perm, kt, ntile; };
struct ConvRegs { f32x4 v0, v1; float s0, s1; };
DI void conv_load(const ConvJob& J, ConvRegs& R, int tid) {
  const int k0 = J.kt * 64, n0 = J.ntile * 64, kk = tid >> 4, n4 = (tid & 15) * 4;
  R.v0 = *reinterpret_cast<const f32x4*>(J.src + (long)(k0 + kk) * J.N + n0 + n4);
  R.v1 = *reinterpret_cast<const f32x4*>(J.src + (long)(k0 + kk + 32) * J.N + n0 + n4);
  R.s0 = J.g ? J.g[k0 + kk] : 1.f; R.s1 = J.g ? J.g[k0 + kk + 32] : 1.f;
}
DI void conv_store(const ConvJob& J, const ConvRegs& R, int tid, char* lds) {
  float* tile = reinterpret_cast<float*>(lds);
  const int k0 = J.kt * 64, n0 = J.ntile * 64;
  { const int kk = tid >> 4, n4 = (tid & 15) * 4;
    tile[kk * 65 + n4 + 0] = R.v0[0] * R.s0; tile[kk * 65 + n4 + 1] = R.v0[1] * R.s0; tile[kk * 65 + n4 + 2] = R.v0[2] * R.s0; tile[kk * 65 + n4 + 3] = R.v0[3] * R.s0;
    tile[(kk + 32) * 65 + n4 + 0] = R.v1[0] * R.s1; tile[(kk + 32) * 65 + n4 + 1] = R.v1[1] * R.s1; tile[(kk + 32) * 65 + n4 + 2] = R.v1[2] * R.s1; tile[(kk + 32) * 65 + n4 + 3] = R.v1[3] * R.s1; }
  __syncthreads();
  {
    const int n = tid >> 3, k8 = (tid & 7) * 8;
    float f[8];
#pragma unroll
    for (int e = 0; e < 8; ++e) f[e] = tile[(k8 + e) * 65 + n];
    u32x4 w = {cvtpk(f[0], f[1]), cvtpk(f[2], f[3]), cvtpk(f[4], f[5]), cvtpk(f[6], f[7])};
    int nn = n0 + n;
    if (J.perm) { const int isup = nn >= DFF ? 1 : 0, jj = nn - isup * DFF; nn = 256 * (jj >> 7) + 128 * isup + (jj & 127); }
    *reinterpret_cast<u32x4*>(J.dst + (long)nn * J.K + k0 + k8) = w;
  }
  __syncthreads();
}

DI void prep_row(const float* __restrict__ src, u16* __restrict__ dstb, float* __restrict__ rstd_out, int lane) {
  f32x4 v[8]; float ss = 0.f;
#pragma unroll
  for (int i = 0; i < 8; ++i) { v[i] = *reinterpret_cast<const f32x4*>(src + lane * 4 + 256 * i); ss += v[i][0] * v[i][0] + v[i][1] * v[i][1] + v[i][2] * v[i][2] + v[i][3] * v[i][3]; }
  ss = wave_sum(ss);
#pragma unroll
  for (int i = 0; i < 8; ++i) { u32x2 w = {cvtpk(v[i][0], v[i][1]), cvtpk(v[i][2], v[i][3])}; *reinterpret_cast<u32x2*>(dstb + lane * 4 + 256 * i) = w; }
  if (lane == 0) *rstd_out = rsqrtf(ss * (1.f / 2048.f) + 1e-6f);
}

DI void phase_convert(const Params& p, char* lds) {
  char* ws = p.ws;
  const int T0 = 32 * 224, T1 = T0 + 1024, T2 = T1 + 1024, T3 = T2 + 1024, T4 = T3 + 256, T5 = T4 + 256, T6 = T5 + 256, T7 = T6 + 256, T8 = T7 + 32 * 176, T9 = T8 + 88 * 32;
  const int ctid = otid();
#define CONV_DECODE(t, J) do { int lt; J.g = nullptr; J.perm = 0; \
    if ((t) < T0)      { lt = (t);      J.src = p.w_in;  J.N = NIN;  J.K = DM;  J.dst = (u16*)(ws + O_WT_IN);  J.g = p.norm_mix_g; } \
    else if ((t) < T1) { lt = (t) - T0; J.src = p.w_pa;  J.N = DM;   J.K = DM;  J.dst = (u16*)(ws + O_WT_PA); } \
    else if ((t) < T2) { lt = (t) - T1; J.src = p.w_pb;  J.N = DM;   J.K = DM;  J.dst = (u16*)(ws + O_WT_PB); } \
    else if ((t) < T3) { lt = (t) - T2; J.src = p.w_out; J.N = DM;   J.K = DM;  J.dst = (u16*)(ws + O_WT_OUT); } \
    else if ((t) < T4) { lt = (t) - T3; J.src = p.w_cq;  J.N = 512;  J.K = DM;  J.dst = (u16*)(ws + O_WT_CQ);  J.g = p.norm_cross_g; } \
    else if ((t) < T5) { lt = (t) - T4; J.src = p.w_ck;  J.N = 512;  J.K = DM;  J.dst = (u16*)(ws + O_WT_CKV); J.g = p.norm_mem_g; } \
    else if ((t) < T6) { lt = (t) - T5; J.src = p.w_cv;  J.N = 512;  J.K = DM;  J.dst = (u16*)(ws + O_WT_CKV) + (long)512 * DM; J.g = p.norm_mem_g; } \
    else if ((t) < T7) { lt = (t) - T6; J.src = p.w_co;  J.N = DM;   J.K = 512; J.dst = (u16*)(ws + O_WT_CO); } \
    else if ((t) < T8) { lt = (t) - T7; J.src = p.w_fi;  J.N = 2 * DFF; J.K = DM; J.dst = (u16*)(ws + O_WT_FI); J.g = p.norm_ffn_g; J.perm = 1; } \
    else               { lt = (t) - T8; J.src = p.w_fo;  J.N = DM;   J.K = DFF; J.dst = (u16*)(ws + O_WT_FO); } \
    const int nkt_ = J.K / 64; J.kt = lt % nkt_; J.ntile = lt / nkt_; } while (0)
  {
    int t = blockIdx.x; ConvRegs R, Rn;
    if (t < T9) { ConvJob J; CONV_DECODE(t, J); conv_load(J, R, ctid); }
    while (t < T9) {
      const int tn = t + gridDim.x;
      if (tn < T9) { ConvJob Jn; CONV_DECODE(tn, Jn); conv_load(Jn, Rn, ctid); }
      { ConvJob J; CONV_DECODE(t, J); conv_store(J, R, ctid, lds); }
      R = Rn; t = tn;
    }
  }
#undef CONV_DECODE
  const int tid = otid(), lane = tid & 63, wid = tid >> 6;
  for (int r = blockIdx.x * 8 + wid; r < NMEMROWS; r += gridDim.x * 8) {
    const float* src = r < 512 ? p.mem_prompt + (long)r * DM : p.mem_sample + (long)(r - 512) * DM;
    prep_row(src, (u16*)(ws + O_MEMB) + (long)r * DM, (float*)(ws + O_MEMRS) + r, lane);
  }
  if (blockIdx.x == 0) {
    float* tab = (float*)(ws + O_BTAB);
    for (int i = tid; i < 8 * 257; i += NT_THREADS) {
      const int h = i / 257, idx = i % 257;
      tab[h * 260 + idx] = p.rel_table[t5_bucket(idx - 128) * 8 + h] * LOG2E;
    }
    if (tid < 8) { float mx = -1e30f; for (int b = 0; b < 32; ++b) mx = fmaxf(mx, p.rel_table[b * 8 + tid]); tab[tid * 260 + 257] = mx * LOG2E; }
  }
}

constexpr int QBLK = 32, KVBLK = 64, NW = 8, HD = 128;
constexpr float SCALE = 0.088388347648318440f;
constexpr float THR2 = 8.f * LOG2E;
constexpr size_t SHM_V = KVBLK * HD * 2, SHM_K = KVBLK * HD * 2;
constexpr size_t SHM_TAB = 2 * SHM_V + 2 * SHM_K + NW * 64 * 4;
#define KSWZ(row, colB) ((row) * 256 + ((colB) ^ (((row) & 7) << 4)))

template <bool BIAS>
DI void partialSM(f32x16& p0, f32x16& p1, float& m_reg, float& mn, float& alpha, float cb, bool near, const float* tab, int rel0, int hi) {
  constexpr float C = SCALE * LOG2E;
  float pmax;
  if (BIAS && near) {
#pragma unroll
    for (int c4 = 0; c4 < 4; ++c4) {
#pragma unroll
      for (int rr = 0; rr < 4; ++rr) {
        const int r = c4 * 4 + rr;
        int rel = rel0 + crow(r, hi); rel = rel < -128 ? -128 : (rel > 128 ? 128 : rel);
        p0[r] = fmaf(p0[r], C, tab[rel + 128]);
        int rel1 = rel0 + 32 + crow(r, hi); rel1 = rel1 < -128 ? -128 : (rel1 > 128 ? 128 : rel1);
        p1[r] = fmaf(p1[r], C, tab[rel1 + 128]);
      }
      SBAR();
    }
    pmax = p0[0];
#pragma unroll
    for (int r = 1; r < 16; ++r) pmax = fmaxf(pmax, p0[r]);
#pragma unroll
    for (int r = 0; r < 16; ++r) pmax = fmaxf(pmax, p1[r]);
  } else {
    pmax = p0[0];
#pragma unroll
    for (int r = 1; r < 16; ++r) pmax = fmaxf(pmax, p0[r]);
#pragma unroll
    for (int r = 0; r < 16; ++r) pmax = fmaxf(pmax, p1[r]);
    pmax = fmaf(pmax, C, cb);
  }
  { auto rr = __builtin_amdgcn_permlane32_swap(__float_as_uint(pmax), __float_as_uint(pmax), false, false);
    pmax = fmaxf(__uint_as_float(rr[0]), __uint_as_float(rr[1])); }
  if (__builtin_expect(__all(pmax - m_reg <= THR2), 1)) { mn = m_reg; alpha = 1.f; }
  else { mn = fmaxf(m_reg, pmax); alpha = __builtin_amdgcn_exp2f(m_reg - mn); m_reg = mn; }
  if (BIAS && near) {
#pragma unroll
    for (int r = 0; r < 16; ++r) { p0[r] -= mn; p1[r] -= mn; }
  } else {
    const float off = cb - mn;
#pragma unroll
    for (int r = 0; r < 16; ++r) { p0[r] = fmaf(p0[r], C, off); p1[r] = fmaf(p1[r], C, off); }
  }
#pragma unroll
  for (int r = 0; r < 16; ++r) p0[r] = __builtin_amdgcn_exp2f(p0[r]);
}
DI void finishSM(f32x16& p0, f32x16& p1, float alpha, float& l_reg, bf16x8& pa0, bf16x8& pa1, bf16x8& pa2, bf16x8& pa3) {
#pragma unroll
  for (int r = 0; r < 16; ++r) p1[r] = __builtin_amdgcn_exp2f(p1[r]);
  float ps = 0;
#pragma unroll
  for (int r = 0; r < 16; ++r) ps += p0[r];
#pragma unroll
  for (int r = 0; r < 16; ++r) ps += p1[r];
  { auto rr = __builtin_amdgcn_permlane32_swap(__float_as_uint(ps), __float_as_uint(ps), false, false);
    ps = __uint_as_float(rr[0]) + __uint_as_float(rr[1]); }
  l_reg = l_reg * alpha + ps;
#define PK4(P, BASE, OUT) do { unsigned a0 = cvtpk(P[BASE + 0], P[BASE + 1]), a1 = cvtpk(P[BASE + 2], P[BASE + 3]);   \
    unsigned b0 = cvtpk(P[BASE + 4], P[BASE + 5]), b1 = cvtpk(P[BASE + 6], P[BASE + 7]);                              \
    auto r0 = __builtin_amdgcn_permlane32_swap(a0, b0, false, false); auto r1 = __builtin_amdgcn_permlane32_swap(a1, b1, false, false); \
    u32x4 w = {r0[0], r1[0], r0[1], r1[1]}; OUT = *reinterpret_cast<bf16x8*>(&w); } while (0)
  PK4(p0, 0, pa0); PK4(p0, 8, pa1); PK4(p1, 0, pa2); PK4(p1, 8, pa3);
#undef PK4
}
DI void qkt(f32x16& p0, f32x16& p1, const char* Ks, const bf16x8* qr, int r32, int hi) {
  p0 = f32x16{}; p1 = f32x16{};
#pragma unroll
  for (int d0 = 0; d0 < 8; ++d0) { int cb = (d0 * 16 + hi * 8) * 2;
    bf16x8 b0 = *reinterpret_cast<const bf16x8*>(Ks + KSWZ(r32, cb));
    bf16x8 b1 = *reinterpret_cast<const bf16x8*>(Ks + KSWZ(32 + r32, cb));
    p0 = __builtin_amdgcn_mfma_f32_32x32x16_bf16(b0, qr[d0], p0, 0, 0, 0);
    p1 = __builtin_amdgcn_mfma_f32_32x32x16_bf16(b1, qr[d0], p1, 0, 0, 0); }
}
DI int v_st(int k, int c) { const int kk = (k & ~0xC) | ((k & 4) << 1) | ((k & 8) >> 1); return ((kk >> 3) * 4 + (c >> 5)) * 512 + ((kk & 7) * 32 + (c & 31)) * 2; }
DI int v_rd_base(int lane) { return ((lane & 3) << 3) | (((lane >> 2) & 3) << 6) | (((lane >> 4) & 1) << 5) | (((lane >> 5) & 1) << 8); }
constexpr int v_rd_off(int d0, int ks, int half) { return d0 * 512 + ks * 4096 + half * 2048; }
template <int OFF> DI s16x4 tr_read(int vb) {
  s16x4 r; asm volatile("ds_read_b64_tr_b16 %0, %1 offset:%2" : "=&v"(r) : "v"(vb), "i"(OFF) : "memory"); return r;
}
template <int D0> DI void pv_one(f32x16& od, int vb, bf16x8 pa0, bf16x8 pa1, bf16x8 pa2, bf16x8 pa3) {
  const s16x4 l0 = tr_read<v_rd_off(D0, 0, 0)>(vb), h0 = tr_read<v_rd_off(D0, 0, 1)>(vb), l1 = tr_read<v_rd_off(D0, 1, 0)>(vb), h1 = tr_read<v_rd_off(D0, 1, 1)>(vb);
  const s16x4 l2 = tr_read<v_rd_off(D0, 2, 0)>(vb), h2 = tr_read<v_rd_off(D0, 2, 1)>(vb), l3 = tr_read<v_rd_off(D0, 3, 0)>(vb), h3 = tr_read<v_rd_off(D0, 3, 1)>(vb);
  asm volatile("s_waitcnt lgkmcnt(0)" ::: "memory"); SBAR();
#define PK(L, H) (bf16x8){L[0], L[1], L[2], L[3], H[0], H[1], H[2], H[3]}
  od = __builtin_amdgcn_mfma_f32_32x32x16_bf16(pa0, PK(l0, h0), od, 0, 0, 0);
  od = __builtin_amdgcn_mfma_f32_32x32x16_bf16(pa1, PK(l1, h1), od, 0, 0, 0);
  od = __builtin_amdgcn_mfma_f32_32x32x16_bf16(pa2, PK(l2, h2), od, 0, 0, 0);
  od = __builtin_amdgcn_mfma_f32_32x32x16_bf16(pa3, PK(l3, h3), od, 0, 0, 0);
#undef PK
}
DI void pv_d0(f32x16* o, int vb, bf16x8 pa0, bf16x8 pa1, bf16x8 pa2, bf16x8 pa3) {
  pv_one<0>(o[0], vb, pa0, pa1, pa2, pa3); pv_one<1>(o[1], vb, pa0, pa1, pa2, pa3); pv_one<2>(o[2], vb, pa0, pa1, pa2, pa3); pv_one<3>(o[3], vb, pa0, pa1, pa2, pa3);
}

template <int LDQ, int LDK, int LDO, bool BIAS>
DI void attn_body(const u16* __restrict__ Qb, const u16* __restrict__ Kh, const u16* __restrict__ Vh, u16* __restrict__ Ob, int seq, int q0, char* lds) {
  const int tid = otid(), wid = tid >> 6, lane = tid & 63, r32 = lane & 31, hi = lane >> 5;
  char* V_lds = lds; char* K_lds = lds + 2 * SHM_V;
  float* ws = (float*)(lds + 2 * SHM_V + 2 * SHM_K) + wid * 64; float* li_l = ws; float* al_l = ws + 32;
  const float* tab = (const float*)(lds + SHM_TAB);
  float m_reg = -1e30f, l_reg = 0; f32x16 o[4] = {}; bf16x8 qr[8];
  const u16* Qw = Qb + (long)(wid * QBLK + r32) * LDQ + hi * 8;
#pragma unroll
  for (int d0 = 0; d0 < 8; ++d0) qr[d0] = ld8(Qw + d0 * 16);
  const int sr = tid >> 4, sc = (tid & 15) * 8, vst0 = v_st(sr, sc), vst1 = v_st(32 + sr, sc);
  const int vb0 = (int)(uintptr_t)V_lds + v_rd_base(lane);
  constexpr int SDEPTH = BIAS ? 1 : 2;
  struct { bf16x8 vs0, vs1, ks0, ks1; } sr_[SDEPTH];
  const int qpos = q0 + wid * QBLK + r32;
  float biasL = 0.f, biasR = 0.f;
#define SLOAD(i, k0) do { sr_[i].vs0 = ld8(&Vh[(long)((k0) + sr) * LDK + sc]); sr_[i].vs1 = ld8(&Vh[(long)((k0) + 32 + sr) * LDK + sc]); \
    sr_[i].ks0 = ld8(&Kh[(long)((k0) + sr) * LDK + sc]); sr_[i].ks1 = ld8(&Kh[(long)((k0) + 32 + sr) * LDK + sc]); } while (0)
#define SWRITE(b, i) do { *(bf16x8*)(V_lds + (b) * SHM_V + vst0) = sr_[i].vs0;          \
    *(bf16x8*)(V_lds + (b) * SHM_V + vst1) = sr_[i].vs1; int kc = sc * 2;               \
    *(bf16x8*)(K_lds + (b) * SHM_K + KSWZ(sr, kc)) = sr_[i].ks0;                       \
    *(bf16x8*)(K_lds + (b) * SHM_K + KSWZ(32 + sr, kc)) = sr_[i].ks1; } while (0)
#define SWAIT() do { if constexpr (SDEPTH == 2) asm volatile("s_waitcnt vmcnt(4)" ::: "memory"); else asm volatile("s_waitcnt vmcnt(0)" ::: "memory"); } while (0)
#define RESC(a) do { if (__any((a) < 1.f)) { if (hi == 0) al_l[r32] = (a); asm volatile("s_waitcnt lgkmcnt(0)" ::: "memory"); \
    _Pragma("unroll") for (int d = 0; d < 4; ++d) _Pragma("unroll") for (int r = 0; r < 16; ++r) o[d][r] *= al_l[crow(r, hi)]; } } while (0)
#define TILE_NEAR(tk) (BIAS && ((tk) * KVBLK + 63 >= q0 - 128) && ((tk) * KVBLK <= q0 + 255 + 128))
#define TILE_CB(tk) (BIAS ? (((tk) * KVBLK > q0) ? biasR : biasL) : 0.f)
#define PSM(P0, P1, MN, AL, tk) partialSM<BIAS>(P0, P1, m_reg, MN, AL, TILE_CB(tk), TILE_NEAR(tk), tab, (tk) * KVBLK - qpos, hi)
  f32x16 pA0, pA1, pB0, pB1; float mnA, mnB, alA, alB; bf16x8 pa0, pa1, pa2, pa3; const int NT = seq / KVBLK;
  constexpr int SE = 0, SO = SDEPTH - 1;
  SLOAD(SE, 0); asm volatile("s_waitcnt vmcnt(0)" ::: "memory"); SWRITE(0, SE); __syncthreads();
  if (BIAS) { biasL = __uint_as_float(__builtin_amdgcn_readfirstlane(__float_as_uint(tab[0]))); biasR = __uint_as_float(__builtin_amdgcn_readfirstlane(__float_as_uint(tab[256]))); }
  qkt(pA0, pA1, K_lds, qr, r32, hi); PSM(pA0, pA1, mnA, alA, 0);
  SLOAD(SO, KVBLK); if constexpr (SDEPTH == 2) { if (2 < NT) SLOAD(SE, 2 * KVBLK); }
  SWAIT(); SWRITE(1, SO); __syncthreads();
  for (int j = 1; j + 1 < NT; j += 2) {
    SBAR(); qkt(pB0, pB1, K_lds + SHM_K, qr, r32, hi);
    finishSM(pA0, pA1, alA, l_reg, pa0, pa1, pa2, pa3); SBAR();
    SLOAD(SO, (j + SDEPTH) * KVBLK); SBAR();
    pv_d0(o, vb0, pa0, pa1, pa2, pa3); PSM(pB0, pB1, mnB, alB, j);
    __syncthreads(); SWAIT(); SWRITE(0, SE);
    RESC(alB); __syncthreads();
    SBAR(); qkt(pA0, pA1, K_lds, qr, r32, hi);
    finishSM(pB0, pB1, alB, l_reg, pa0, pa1, pa2, pa3); SBAR();
    if (SDEPTH == 1 || j + 3 < NT) SLOAD(SE, (j + 1 + SDEPTH) * KVBLK); SBAR();
    pv_d0(o, vb0 + (int)SHM_V, pa0, pa1, pa2, pa3); PSM(pA0, pA1, mnA, alA, j + 1);
    __syncthreads(); SWAIT(); SWRITE(1, SO);
    RESC(alA); __syncthreads();
  }
  SBAR(); qkt(pB0, pB1, K_lds + SHM_K, qr, r32, hi);
  finishSM(pA0, pA1, alA, l_reg, pa0, pa1, pa2, pa3); SBAR();
  pv_d0(o, vb0, pa0, pa1, pa2, pa3); PSM(pB0, pB1, mnB, alB, NT - 1);
  __syncthreads(); RESC(alB);
  finishSM(pB0, pB1, alB, l_reg, pa0, pa1, pa2, pa3); SBAR();
  pv_d0(o, vb0 + (int)SHM_V, pa0, pa1, pa2, pa3);
  if (hi == 0) li_l[r32] = l_reg; asm volatile("s_waitcnt lgkmcnt(0)" ::: "memory");
  float rli[16];
#pragma unroll
  for (int r = 0; r < 16; ++r) rli[r] = __builtin_amdgcn_rcpf(li_l[crow(r, hi)]);
  {
    constexpr int OROW = 272;
    __syncthreads();
#pragma unroll
    for (int r = 0; r < 16; ++r) { const int orow = wid * QBLK + crow(r, hi);
#pragma unroll
      for (int d0 = 0; d0 < 4; ++d0) *reinterpret_cast<u16*>(lds + orow * OROW + (d0 * 32 + r32) * 2) = f2bf(o[d0][r] * rli[r]); }
    __syncthreads();
    bf16x8 orr[8];
#pragma unroll
    for (int it = 0; it < 8; ++it) orr[it] = *reinterpret_cast<const bf16x8*>(lds + ((tid >> 4) + 32 * it) * OROW + (tid & 15) * 16);
#pragma unroll
    for (int it = 0; it < 8; ++it) *reinterpret_cast<bf16x8*>(Ob + (long)((tid >> 4) + 32 * it) * LDO + (tid & 15) * 8) = orr[it];
  }
#undef SLOAD
#undef SWRITE
#undef SWAIT
#undef RESC
#undef TILE_NEAR
#undef TILE_CB
#undef PSM
}

constexpr int DA_V = 0, DA_K = 65536, DA_P = 98304, DA_L = 131072, DA_TAB = 132096;
template <int PROBE, int MODE>
DI void dattn_body(const u16* __restrict__ Qb, const u16* __restrict__ Kh, const u16* __restrict__ Vh, u16* __restrict__ Ob, const u16* __restrict__ O1, float lam, const float* __restrict__ subg, int seq, int q0, float kmax2, char* lds) {
  const int tid = otid(), wid = tid >> 6, lane = tid & 63, r32 = lane & 31, hi = lane >> 5, rg = wid >> 1, kh = wid & 1;
  char* V_lds = lds + DA_V; char* K_lds = lds + DA_K; char* P_lds = lds + DA_P; float* lsum = (float*)(lds + DA_L); const float* tab = (const float*)(lds + DA_TAB);
  constexpr float C = SCALE * LOG2E;
  bf16x8 qr[8];
  const u16* Qw = Qb + (long)(rg * 32 + r32) * DM + hi * 8;
#pragma unroll
  for (int d0 = 0; d0 < 8; ++d0) qr[d0] = ld8(Qw + d0 * 16);
  float q2 = 0.f;
#pragma unroll
  for (int d0 = 0; d0 < 8; ++d0)
#pragma unroll
    for (int e = 0; e < 8; ++e) { const float f = bf2f((u16)qr[d0][e]); q2 = fmaf(f, f, q2); }
  { auto rr = __builtin_amdgcn_permlane32_swap(__float_as_uint(q2), __float_as_uint(q2), false, false); q2 = __uint_as_float(rr[0]) + __uint_as_float(rr[1]); }
  const int sr = tid >> 4, sc = (tid & 15) * 8, vst0 = v_st(sr, sc), vst1 = v_st(32 + sr, sc), kst0 = KSWZ(sr, sc * 2), kst1 = KSWZ(32 + sr, sc * 2);
  const int vb0 = (int)(uintptr_t)V_lds + kh * 16384 + v_rd_base(lane);
  const int qpos = q0 + rg * 32 + r32;
  char* pw = P_lds + wid * 2048 + lane * 32;
  const char* pr = P_lds + (wid ^ 1) * 2048 + lane * 32;
  const int wu = __builtin_amdgcn_readfirstlane(wid);
  unsigned koff[2], voff[2];
#pragma unroll
  for (int i = 0; i < 2; ++i) {
    const int a = i * 8192 + wid * 1024 + lane * 16;
    { const int row = a >> 8, pch = (a & 255) >> 4, c = pch ^ (row & 7); koff[i] = (unsigned)(row * DM + c * 8) * 2u; }
    { const int q = a >> 4, sub = q >> 5, kk = (sub >> 2) * 8 + ((q & 31) >> 2), k = (kk & ~0xC) | ((kk & 4) << 1) | ((kk & 8) >> 1), col = (sub & 3) * 32 + (q & 3) * 8;
      voff[i] = (unsigned)(k * DM + col) * 2u; }
  }
#define DMA16(gp, lp) __builtin_amdgcn_global_load_lds((const unsigned*)(gp), (PG8_LAS unsigned*)(lp), 16, 0, 0)
#define KDMA(k0, b) do { const char* g_ = (const char*)(Kh + (long)(k0) * DM); char* l_ = K_lds + (b) * 16384 + wu * 1024; \
    DMA16(g_ + koff[0], l_); DMA16(g_ + koff[1], l_ + 8192); } while (0)
#define VDMA(k0, b) do { const char* g_ = (const char*)(Vh + (long)(k0) * DM); char* l_ = V_lds + (b) * 32768 + wu * 1024; \
    DMA16(g_ + voff[0], l_); DMA16(g_ + voff[1], l_ + 8192); DMA16(g_ + voff[0] + 256, l_ + 16384); DMA16(g_ + voff[1] + 256, l_ + 16384 + 8192); } while (0)
#define DMAWAIT() asm volatile("s_waitcnt vmcnt(0)" ::: "memory")
#define QKH(b) do { S = f32x16{}; const char* Ks_ = K_lds + (b) * 16384; _Pragma("unroll") for (int d0 = 0; d0 < 8; ++d0) { \
    const bf16x8 kf = *reinterpret_cast<const bf16x8*>(Ks_ + KSWZ(32 * kh + r32, (d0 * 16 + hi * 8) * 2)); \
    S = __builtin_amdgcn_mfma_f32_32x32x16_bf16(kf, qr[d0], S, 0, 0, 0); } } while (0)
#define PK4S(BASE, OUT) do { unsigned a0 = cvtpk(S[BASE + 0], S[BASE + 1]), a1 = cvtpk(S[BASE + 2], S[BASE + 3]);   \
    unsigned b0 = cvtpk(S[BASE + 4], S[BASE + 5]), b1 = cvtpk(S[BASE + 6], S[BASE + 7]);                              \
    auto r0 = __builtin_amdgcn_permlane32_swap(a0, b0, false, false); auto r1 = __builtin_amdgcn_permlane32_swap(a1, b1, false, false); \
    u32x4 w = {r0[0], r1[0], r0[1], r1[1]}; OUT = *reinterpret_cast<bf16x8*>(&w); } while (0)
#define SMX_CH(c4) do { if (near_) { _Pragma("unroll") for (int rr = 0; rr < 4; ++rr) { const int r = (c4) * 4 + rr; \
        int rel = rel0_ + crow(r, hi); rel = rel < -128 ? -128 : (rel > 128 ? 128 : rel); S[r] = fmaf(S[r], C, tab[rel + 128] - Mrow); } } \
    else { _Pragma("unroll") for (int rr = 0; rr < 4; ++rr) { const int r = (c4) * 4 + rr; S[r] = fmaf(S[r], C, off_); } } \
    _Pragma("unroll") for (int rr = 0; rr < 4; ++rr) { const int r = (c4) * 4 + rr; S[r] = __builtin_amdgcn_exp2f(S[r]); } } while (0)
#define SMX_SETUP(tk) const int k0_ = (tk) * KVBLK; const bool near_ = (k0_ + 63 >= q0 - 128) && (k0_ <= q0 + 127 + 128); \
    const int rel0_ = k0_ + 32 * kh - qpos; const float off_ = ((k0_ > q0) ? biasR : biasL) - Mrow;
#define SMX_FIN(pbuf) do { _Pragma("unroll") for (int r = 0; r < 16; ++r) l_reg += S[r]; \
    PK4S(0, po0); PK4S(8, po1); \
    *(bf16x8*)(pw + (pbuf) * 16384) = po0; *(bf16x8*)(pw + (pbuf) * 16384 + 16) = po1; } while (0)
#define VRD(D0, X) do { X##0 = tr_read<v_rd_off(D0, 0, 0)>(vb); X##1 = tr_read<v_rd_off(D0, 0, 1)>(vb); X##2 = tr_read<v_rd_off(D0, 1, 0)>(vb); X##3 = tr_read<v_rd_off(D0, 1, 1)>(vb); \
    X##4 = tr_read<v_rd_off(D0, 2, 0)>(vb); X##5 = tr_read<v_rd_off(D0, 2, 1)>(vb); X##6 = tr_read<v_rd_off(D0, 3, 0)>(vb); X##7 = tr_read<v_rd_off(D0, 3, 1)>(vb); } while (0)
#define VPK(L, H) (bf16x8){L[0], L[1], L[2], L[3], H[0], H[1], H[2], H[3]}
#define VMM(D0, X) do { o[D0] = __builtin_amdgcn_mfma_f32_32x32x16_bf16(A0, VPK(X##0, X##1), o[D0], 0, 0, 0); o[D0] = __builtin_amdgcn_mfma_f32_32x32x16_bf16(A1, VPK(X##2, X##3), o[D0], 0, 0, 0); \
    o[D0] = __builtin_amdgcn_mfma_f32_32x32x16_bf16(A2, VPK(X##4, X##5), o[D0], 0, 0, 0); o[D0] = __builtin_amdgcn_mfma_f32_32x32x16_bf16(A3, VPK(X##6, X##7), o[D0], 0, 0, 0); } while (0)
#define LWAIT() do { asm volatile("s_waitcnt lgkmcnt(0)" ::: "memory"); SBAR(); } while (0)
  f32x16 o[4] = {}; f32x16 S; float l_reg = 0.f; bf16x8 po0, po1; const int NT = seq / KVBLK;
  KDMA(0, 0); VDMA(0, 0); KDMA(KVBLK, 1);
  DMAWAIT();
  __syncthreads();
  const float biasL = __uint_as_float(__builtin_amdgcn_readfirstlane(__float_as_uint(tab[0]))), biasR = __uint_as_float(__builtin_amdgcn_readfirstlane(__float_as_uint(tab[256])));
  const float Mrow = C * __builtin_sqrtf(q2 * kmax2) + tab[257];
  QKH(0);
  { SMX_SETUP(0) SMX_CH(0); SMX_CH(1); SMX_CH(2); SMX_CH(3); SMX_FIN(0); }
  __syncthreads();
  for (int j = 0; j < NT; ++j) {
    const bool more = j + 1 < NT;
    if (!(PROBE & 1)) {
      if (j + 2 < NT) KDMA((j + 2) * KVBLK, j & 1);
      if (more) VDMA((j + 1) * KVBLK, (j + 1) & 1);
    }
    bf16x8 kf[8];
    if (more) { const char* Ks_ = K_lds + ((j + 1) & 1) * 16384;
#pragma unroll
      for (int d0 = 0; d0 < 8; ++d0) kf[d0] = *reinterpret_cast<const bf16x8*>(Ks_ + KSWZ(32 * kh + r32, (d0 * 16 + hi * 8) * 2)); }
    const bf16x8 pb0 = *(const bf16x8*)(pr + (j & 1) * 16384), pb1 = *(const bf16x8*)(pr + (j & 1) * 16384 + 16);
    const int vb = vb0 + (j & 1) * 32768;
    s16x4 va0, va1, va2, va3, va4, va5, va6, va7, vc0, vc1, vc2, vc3, vc4, vc5, vc6, vc7;
    VRD(0, va);
    if (more) { asm volatile("s_waitcnt lgkmcnt(10)" ::: "memory"); SBAR();
      if (!(PROBE & 4)) { S = f32x16{};
#pragma unroll
      for (int d0 = 0; d0 < 8; ++d0) S = __builtin_amdgcn_mfma_f32_32x32x16_bf16(kf[d0], qr[d0], S, 0, 0, 0); }
      SBAR(); }
    const bf16x8 A0 = kh ? pb0 : po0, A1 = kh ? pb1 : po1, A2 = kh ? po0 : pb0, A3 = kh ? po1 : pb1;
    SMX_SETUP(j + 1)
#define VMMP(D0, X) do { if (!(PROBE & 8)) VMM(D0, X); } while (0)
#define SMXP(c) do { if (!(PROBE & 2)) { if (more) SMX_CH(c); } } while (0)
    LWAIT(); VRD(1, vc); VMMP(0, va); SMXP(0);
    LWAIT(); VRD(2, va); VMMP(1, vc); SMXP(1);
    LWAIT(); VRD(3, vc); VMMP(2, va); SMXP(2);
    LWAIT(); VMMP(3, vc); SMXP(3);
    if (!(PROBE & 2)) { if (more) SMX_FIN((j + 1) & 1); }
    DMAWAIT();
    __syncthreads();
#undef VMMP
#undef SMXP
  }
  { auto rr = __builtin_amdgcn_permlane32_swap(__float_as_uint(l_reg), __float_as_uint(l_reg), false, false); l_reg = __uint_as_float(rr[0]) + __uint_as_float(rr[1]); }
  if (hi == 0) lsum[wid * 32 + r32] = l_reg;
  __syncthreads();
  float rli[16];
#pragma unroll
  for (int r = 0; r < 16; ++r) rli[r] = __builtin_amdgcn_rcpf(lsum[wid * 32 + crow(r, hi)] + lsum[(wid ^ 1) * 32 + crow(r, hi)]);
  u16* Ow = Ob + (long)(rg * 32) * 4096 + kh * 128;
  if (PROBE) {
    float acc_ = 0.f;
#pragma unroll
    for (int r = 0; r < 16; ++r)
#pragma unroll
      for (int d0 = 0; d0 < 4; ++d0) acc_ += o[d0][r] * rli[r];
    if (acc_ == 123.456f && seq < 0) Ow[0] = f2bf(acc_);
    return;
  }
  (void)Ow;
  {
    char* Ot = lds;
    constexpr int UOROW = 528;
#pragma unroll
    for (int r = 0; r < 16; ++r) { const int orow = rg * 32 + crow(r, hi);
#pragma unroll
      for (int d0 = 0; d0 < 4; ++d0) *reinterpret_cast<u16*>(Ot + orow * UOROW + (kh * 128 + d0 * 32 + r32) * 2) = f2bf(o[d0][r] * rli[r]); }
    __syncthreads();
    if (MODE == 0) {
#pragma unroll
      for (int it = 0; it < 8; ++it) {
        const int row = (tid >> 5) + 16 * it, c8 = (tid & 31) * 8;
        *reinterpret_cast<bf16x8*>(Ob + (long)row * DM + c8) = *reinterpret_cast<const bf16x8*>(Ot + row * UOROW + c8 * 2);
      }
    } else {
      const int c8 = (tid & 31) * 8;
      const f32x4 sg0 = *reinterpret_cast<const f32x4*>(subg + c8), sg1 = *reinterpret_cast<const f32x4*>(subg + c8 + 4);
      u32x4 a1[8];
#pragma unroll
      for (int it = 0; it < 8; ++it) a1[it] = *reinterpret_cast<const u32x4*>(O1 + (long)((tid >> 5) + 16 * it) * DM + c8);
#pragma unroll
      for (int it = 0; it < 8; ++it) {
        const int row = (tid >> 5) + 16 * it;
        const u32x4 a2 = *reinterpret_cast<const u32x4*>(Ot + row * UOROW + c8 * 2);
        f32x4 v0 = bf4lo(a1[it]) - bf4lo(a2) * lam, v1 = bf4hi(a1[it]) - bf4hi(a2) * lam;
        float ss = 0.f;
#pragma unroll
        for (int e = 0; e < 4; ++e) ss = fmaf(v0[e], v0[e], fmaf(v1[e], v1[e], ss));
        ss += __shfl_xor(ss, 1, 64); ss += __shfl_xor(ss, 2, 64); ss += __shfl_xor(ss, 4, 64); ss += __shfl_xor(ss, 8, 64); ss += __shfl_xor(ss, 16, 64);
        const float sc = rsqrtf(ss * (1.f / 256.f) + 1e-5f) * 0.8f;
        *reinterpret_cast<u32x4*>(Ob + (long)row * DM + c8) = pack8(v0 * sg0 * sc, v1 * sg1 * sc);
      }
    }
  }
#undef DMA16
#undef KDMA
#undef VDMA
#undef DMAWAIT
#undef QKH
#undef PK4S
#undef SMX_CH
#undef SMX_SETUP
#undef SMX_FIN
#undef VRD
#undef VPK
#undef VMM
#undef LWAIT
}

constexpr int GROW = 272;
constexpr int UROW = 528;
DI void gating_item(const Params& p, int tok0, int gi, char* lds) {
  char* ws = p.ws;
  const u16* U = (const u16*)(ws + O_SEG); const u16* VA = (const u16*)(ws + O_SEG + SEGSZ); u16* OA = (u16*)(ws + O_XB);
  const float* ST = (const float*)(ws + O_LNST);
  char* Ut = lds + 256 * GROW; float* bs = (float*)(Ut + 128 * UROW); float* lnl = bs + 128;
  const int tid = otid(), wid = tid >> 6, lane = tid & 63, r32 = lane & 31, hi = lane >> 5;
  bf16x8 ur[8], vr[8];
  const int j = (wid & 1) * 64 + lane;
#pragma unroll
  for (int it = 0; it < 8; ++it) ur[it] = ld8(U + (long)(tok0 + (tid >> 5) + 16 * it) * DM + gi * 256 + (tid & 31) * 8);
#pragma unroll
  for (int it = 0; it < 8; ++it) vr[it] = ld8(VA + (long)(tok0 + j) * DM + gi * 256 + ((wid >> 1) + 4 * it) * 8);
  const float lnv = tid < 256 ? p.ln_v_g[gi * 256 + tid] : p.ln_v_b[gi * 256 + tid - 256];
  const float bsv = p.b_spatial[gi * 128 + (tid & 127)];
  const float mean = ST[2 * (tok0 + j)] * (1.f / 2048.f), rs = rsqrtf(fmaxf(ST[2 * (tok0 + j) + 1] * (1.f / 2048.f) - mean * mean, 0.f) + 1e-6f);
  SBAR();
#pragma unroll
  for (int it = 0; it < 8; ++it) *reinterpret_cast<bf16x8*>(Ut + ((tid >> 5) + 16 * it) * UROW + (tid & 31) * 16) = ur[it];
  lnl[tid] = lnv;
  if (tid < 128) bs[tid] = bsv;
  __syncthreads();
#pragma unroll
  for (int it = 0; it < 8; ++it) {
    const int d8 = ((wid >> 1) + 4 * it) * 8;
    const f32x4 g0 = *reinterpret_cast<const f32x4*>(lnl + d8), g1 = *reinterpret_cast<const f32x4*>(lnl + d8 + 4);
    const f32x4 b0 = *reinterpret_cast<const f32x4*>(lnl + 256 + d8), b1 = *reinterpret_cast<const f32x4*>(lnl + 256 + d8 + 4);
#pragma unroll
    for (int e = 0; e < 8; ++e) {
      const float y = (bf2f((u16)vr[it][e]) - mean) * rs * (e < 4 ? g0[e & 3] : g1[e & 3]) + (e < 4 ? b0[e & 3] : b1[e & 3]);
      *reinterpret_cast<u16*>(lds + (d8 + e) * GROW + j * 2) = f2bf(y);
    }
  }
  __syncthreads();
  f32x16 acc[4] = {};
  const float* W = p.w_spatial + (long)gi * 128 * 128;
#pragma unroll
  for (int kq = 0; kq < 4; ++kq) {
    f32x4 wv[2][4][2];
#pragma unroll
    for (int k2 = 0; k2 < 2; ++k2)
#pragma unroll
      for (int mi = 0; mi < 4; ++mi) {
        const float* wp = W + (mi * 32 + r32) * 128 + (kq * 2 + k2) * 16 + hi * 8;
        wv[k2][mi][0] = *reinterpret_cast<const f32x4*>(wp); wv[k2][mi][1] = *reinterpret_cast<const f32x4*>(wp + 4);
      }
    SBAR();
#pragma unroll
    for (int k2 = 0; k2 < 2; ++k2) {
      const int ks = kq * 2 + k2;
      const bf16x8 b = *reinterpret_cast<const bf16x8*>(lds + (32 * wid + r32) * GROW + ks * 32 + hi * 16);
#pragma unroll
      for (int mi = 0; mi < 4; ++mi) {
        const f32x4 w0 = wv[k2][mi][0], w1 = wv[k2][mi][1];
        u32x4 aw = {cvtpk(w0[0], w0[1]), cvtpk(w0[2], w0[3]), cvtpk(w1[0], w1[1]), cvtpk(w1[2], w1[3])};
        acc[mi] = __builtin_amdgcn_mfma_f32_32x32x16_bf16(*reinterpret_cast<bf16x8*>(&aw), b, acc[mi], 0, 0, 0);
      }
    }
    SBAR();
  }
#pragma unroll
  for (int mi = 0; mi < 4; ++mi)
#pragma unroll
    for (int i = 0; i < 16; ++i) {
      const int ii = mi * 32 + crow(i, hi);
      u16* up = reinterpret_cast<u16*>(Ut + ii * UROW + (32 * wid + r32) * 2);
      *up = f2bf(bf2f(*up) * (acc[mi][i] + bs[ii]));
    }
  __syncthreads();
  bf16x8 orr[8];
#pragma unroll
  for (int it = 0; it < 8; ++it) orr[it] = *reinterpret_cast<const bf16x8*>(Ut + ((tid >> 5) + 16 * it) * UROW + (tid & 31) * 16);
#pragma unroll
  for (int it = 0; it < 8; ++it) *reinterpret_cast<bf16x8*>(OA + (long)(tok0 + (tid >> 5) + 16 * it) * DM + gi * 256 + (tid & 31) * 8) = orr[it];
  __syncthreads();
}

DI const float* group_x(const Params& p, int g) { return g < 2 ? p.x_prompt + (long)g * GT * DM : p.x_sample + (long)(g - 2) * GT * DM; }

DI void run_phase(const Params& p, int ph, char* lds, int sel = 0) {
  char* ws = p.ws;
  const int tid = otid(), lane = tid & 63, wid = tid >> 6;
  if (ph == 0) { if (PH_MASK & 0x4000) phase_convert(p, lds); return; }
  if (ph == 1) { if (!(PH_MASK & 0x8000)) return;
    EpiScaleBf16 E{(u16*)(ws + O_MEMKV), 1024, (const float*)(ws + O_MEMRS), nullptr};
    run_gemm(lds, (const u16*)(ws + O_MEMB), (const u16*)(ws + O_WT_CKV), NMEMROWS, 1024, DM, E);
    return;
  }
  constexpr int kSeq[11] = {0, 1, 2, 4, 5, 7, 8, 9, 11, 12, 13};
  const int g = (ph - 2) / 11, kq = (ph - 2) % 11;
  int sp = 0;
#pragma unroll
  for (int q = 0; q < 11; ++q) sp = (kq == q) ? kSeq[q] : sp;
  float* xout = p.out + (long)g * GT * DM;
  u16* XB = (u16*)(ws + O_XB); float* RSTD = (float*)(ws + O_RSTD);
  u16* SEG = (u16*)(ws + O_SEG);
  const long SEGE = (long)GT * DM;
  if (!((PH_MASK >> sp) & 1)) return;
  switch (sp) {
    case 0: case 6: case 10: {
      const float* src = sp == 0 ? group_x(p, g) : xout;
      {
        const int step = gridDim.x * 8;
        int r = blockIdx.x * 8 + wid;
        for (; r + step < GT; r += 2 * step) {
          const float* sa = src + (long)r * DM; const float* sb = src + (long)(r + step) * DM;
          f32x4 va[8], vb[8]; float ssa = 0.f, ssb = 0.f;
#pragma unroll
          for (int i = 0; i < 8; ++i) { va[i] = *reinterpret_cast<const f32x4*>(sa + lane * 4 + 256 * i); vb[i] = *reinterpret_cast<const f32x4*>(sb + lane * 4 + 256 * i); }
#pragma unroll
          for (int i = 0; i < 8; ++i) { ssa += va[i][0] * va[i][0] + va[i][1] * va[i][1] + va[i][2] * va[i][2] + va[i][3] * va[i][3]; ssb += vb[i][0] * vb[i][0] + vb[i][1] * vb[i][1] + vb[i][2] * vb[i][2] + vb[i][3] * vb[i][3]; }
          ssa = wave_sum(ssa); ssb = wave_sum(ssb);
          const float ra = rsqrtf(ssa * (1.f / 2048.f) + 1e-6f), rb = rsqrtf(ssb * (1.f / 2048.f) + 1e-6f);
#pragma unroll
          for (int i = 0; i < 8; ++i) { u32x2 wa = {cvtpk(va[i][0] * ra, va[i][1] * ra), cvtpk(va[i][2] * ra, va[i][3] * ra)}; *reinterpret_cast<u32x2*>(XB + (long)r * DM + lane * 4 + 256 * i) = wa;
            u32x2 wb = {cvtpk(vb[i][0] * rb, vb[i][1] * rb), cvtpk(vb[i][2] * rb, vb[i][3] * rb)}; *reinterpret_cast<u32x2*>(XB + (long)(r + step) * DM + lane * 4 + 256 * i) = wb; }
        }
        for (; r < GT; r += step) {
          const float* sa = src + (long)r * DM; f32x4 va[8]; float ssa = 0.f;
#pragma unroll
          for (int i = 0; i < 8; ++i) { va[i] = *reinterpret_cast<const f32x4*>(sa + lane * 4 + 256 * i); ssa += va[i][0] * va[i][0] + va[i][1] * va[i][1] + va[i][2] * va[i][2] + va[i][3] * va[i][3]; }
          ssa = wave_sum(ssa); const float ra = rsqrtf(ssa * (1.f / 2048.f) + 1e-6f);
#pragma unroll
          for (int i = 0; i < 8; ++i) { u32x2 wa = {cvtpk(va[i][0] * ra, va[i][1] * ra), cvtpk(va[i][2] * ra, va[i][3] * ra)}; *reinterpret_cast<u32x2*>(XB + (long)r * DM + lane * 4 + 256 * i) = wa; }
        }
      }
      if (sp == 0 && blockIdx.x == 0 && tid < 32) ((float*)(ws + O_BTAB + 12288))[tid] = 0.f;
      if (sp == 0) { float* z = (float*)(ws + O_LNST); for (int i = blockIdx.x * NT_THREADS + tid; i < 4 * GT; i += gridDim.x * NT_THREADS) z[i] = 0.f; }
    } break;
    case 14: {
      const int nseq = g < 2 ? 1 : 2, slen = GT / nseq;
      const u16* Kp = SEG + 3 * SEGE; unsigned* kmax = (unsigned*)(ws + O_BTAB + 12288);
      {
        const u16* VAp = SEG + SEGE; float* ST = (float*)(ws + O_LNST);
#pragma unroll 2
        for (int r = blockIdx.x * 8 + wid; r < GT; r += gridDim.x * 8) {
          float s1 = 0.f, s2 = 0.f;
#pragma unroll
          for (int i = 0; i < 4; ++i) { const bf16x8 v = ld8(VAp + (long)r * DM + lane * 8 + 512 * i);
#pragma unroll
            for (int e = 0; e < 8; ++e) { const float f = bf2f((u16)v[e]); s1 += f; s2 = fmaf(f, f, s2); } }
          s1 = wave_sum(s1); s2 = wave_sum(s2);
          if (lane == 0) { const float mean = s1 * (1.f / 2048.f); const float var = fmaxf(s2 * (1.f / 2048.f) - mean * mean, 0.f); ST[2 * r] = mean; ST[2 * r + 1] = rsqrtf(var + 1e-6f); }
        }
      }
      for (int sq = 0; sq < nseq; ++sq) {
        float mx[4] = {0.f, 0.f, 0.f, 0.f};
        for (int r = sq * slen + blockIdx.x * 8 + wid; r < (sq + 1) * slen; r += gridDim.x * 8) {
#pragma unroll
          for (int i = 0; i < 4; ++i) {
            const bf16x8 v = ld8(Kp + (long)r * DM + lane * 8 + 512 * i);
            float ss = 0.f;
#pragma unroll
            for (int e = 0; e < 8; ++e) { const float f = bf2f((u16)v[e]); ss = fmaf(f, f, ss); }
            ss += __shfl_xor(ss, 1, 64); ss += __shfl_xor(ss, 2, 64); ss += __shfl_xor(ss, 4, 64); ss += __shfl_xor(ss, 8, 64);
            mx[i] = fmaxf(mx[i], ss);
          }
        }
        if ((lane & 15) == 0) {
#pragma unroll
          for (int i = 0; i < 4; ++i) atomicMax(kmax + sq * 16 + (lane >> 4) + 4 * i, __float_as_uint(mx[i]));
        }
      }
    } break;
    case 1: {
      EpiInproj E{SEG, RSTD, (float*)(ws + O_LNST), (unsigned*)(ws + O_BTAB + 12288), g < 2 ? GT : GT / 2};
      run_gemm(lds, XB, (const u16*)(ws + O_WT_IN), GT, NIN, DM, E);
    } break;
    case 2: {
      const int nseq = g < 2 ? 1 : 2, slen = GT / nseq, nqb = slen / 128;
      const u16* Q = SEG + 2 * SEGE; const u16* Kp = SEG + 3 * SEGE; const u16* Vp = SEG + 4 * SEGE; u16* OP = (u16*)(ws + O_OP);
      const float* gtab = (const float*)(ws + O_BTAB); const float* kmax = (const float*)(ws + O_BTAB + 12288);
      float lam;
      { float s1 = p.lq1[lane] * p.lk1[lane] + p.lq1[lane + 64] * p.lk1[lane + 64];
        float s2 = p.lq2[lane] * p.lk2[lane] + p.lq2[lane + 64] * p.lk2[lane + 64];
        s1 = wave_sum(s1); s2 = wave_sum(s2); lam = expf(s1) - expf(s2) + 0.2f; }
      u16* O1s = OP; u16* OBn = (u16*)(ws + O_OP + SEGSZ);
      for (int it = blockIdx.x; it < 1024 && sel != 2; it += gridDim.x) {
        const int qb = it % nqb; const int r = it / nqb; const int h = r & 7, sq = r >> 3;
        __syncthreads();
        if (tid < 258) ((float*)(lds + DA_TAB))[tid] = gtab[h * 260 + tid];
        const long t0 = (long)sq * slen, tq = t0 + qb * 128;
        dattn_body<0, 0>(Q + tq * DM + h * 256, Kp + t0 * DM + h * 256, Vp + t0 * DM + h * 256,
                         O1s + tq * DM + h * 256, nullptr, lam, p.subln_g, slen, qb * 128, kmax[sq * 16 + h * 2], lds);
        __syncthreads();
        dattn_body<0, 1>(Q + tq * DM + h * 256 + 128, Kp + t0 * DM + h * 256 + 128, Vp + t0 * DM + h * 256,
                         OBn + tq * DM + h * 256, O1s + tq * DM + h * 256, lam, p.subln_g, slen, qb * 128, kmax[sq * 16 + h * 2 + 1], lds);
      }
      for (int it = 2048 + blockIdx.x; it < 2048 + 1024 && sel != 1; it += gridDim.x) {
        const int gi_ = (it - 2048) & 7, c = (it - 2048) >> 3;
        __syncthreads();
        gating_item(p, c * 128, gi_, lds);
      }
    } break;
    case 3: {
      float s1 = p.lq1[lane] * p.lk1[lane] + p.lq1[lane + 64] * p.lk1[lane + 64];
      float s2 = p.lq2[lane] * p.lk2[lane] + p.lq2[lane + 64] * p.lk2[lane + 64];
      s1 = wave_sum(s1); s2 = wave_sum(s2);
      const float lam = expf(s1) - expf(s2) + 0.2f;
      const u16* OP = (const u16*)(ws + O_OP); u16* OB = SEG + SEGE;
      f32x4 sg = *reinterpret_cast<const f32x4*>(p.subln_g + lane * 4);
#pragma unroll 2
      for (int r = blockIdx.x * 8 + wid; r < GT; r += gridDim.x * 8) {
#pragma unroll
        for (int h = 0; h < 8; ++h) {
          const u16* o1 = OP + (long)r * 4096 + h * 512 + lane * 4;
          u32x2 a = *reinterpret_cast<const u32x2*>(o1), b = *reinterpret_cast<const u32x2*>(o1 + 256);
          float o0 = bflo(a[0]) - lam * bflo(b[0]), o1f = bfhi(a[0]) - lam * bfhi(b[0]), o2 = bflo(a[1]) - lam * bflo(b[1]), o3 = bfhi(a[1]) - lam * bfhi(b[1]);
          float ss = wave_sum(o0 * o0 + o1f * o1f + o2 * o2 + o3 * o3);
          const float sc = rsqrtf(ss * (1.f / 256.f) + 1e-5f) * 0.8f;
          u32x2 w = {cvtpk(o0 * sc * sg[0], o1f * sc * sg[1]), cvtpk(o2 * sc * sg[2], o3 * sc * sg[3])};
          *reinterpret_cast<u32x2*>(OB + (long)r * DM + h * 256 + lane * 4) = w;
        }
      }
    } break;
    case 4: {
      EpiMerge1 E1{xout, SEG + 5 * SEGE};
      run_gemm(lds, XB, (const u16*)(ws + O_WT_PA), GT, DM, DM, E1);
      EpiMerge2 E2{xout, SEG + 6 * SEGE, SEG};
      run_gemm(lds, (const u16*)(ws + O_OP + SEGSZ), (const u16*)(ws + O_WT_PB), GT, DM, DM, E2);
    } break;
    case 5: {
      EpiResidNorm E{group_x(p, g), sel == 3 ? (float*)(ws + O_OP) : xout, sel == 3 ? SEG + 6 * SEGE : XB, sel == 3 ? (float*)(ws + O_LNST) : (float*)(ws + O_SS2)};
      run_gemm(lds, SEG, (const u16*)(ws + O_WT_OUT), GT, DM, DM, E);
    } break;
    case 7: {
      EpiScaleBf16 E{SEG + 2 * SEGE, 512, nullptr, (const float*)(ws + O_SS2)};
      run_gemm(lds, XB, (const u16*)(ws + O_WT_CQ), GT, 512, DM, E);
    } break;
    case 8: {
      const u16* QC = SEG + 2 * SEGE; u16* OC = SEG + 3 * SEGE; const u16* MKV = (const u16*)(ws + O_MEMKV);
      for (int it = blockIdx.x; it < 256; it += gridDim.x) {
        const int h = it & 3, qb = it >> 2;
        const int tq = qb * 256;
        const int mseq = g < 2 ? g : 2 + 2 * (g - 2) + (tq >= 8192 ? 1 : 0);
        __syncthreads();
        attn_body<512, 1024, 512, false>(QC + (long)tq * 512 + h * 128, MKV + (long)mseq * 256 * 1024 + h * 128, MKV + (long)mseq * 256 * 1024 + 512 + h * 128,
                                         OC + (long)tq * 512 + h * 128, 256, 0, lds);
      }
    } break;
    case 9: {
      EpiResidNorm E{xout, sel == 3 ? (float*)(ws + O_OP) : xout, sel == 3 ? SEG + 6 * SEGE : XB, sel == 3 ? (float*)(ws + O_LNST) : (float*)(ws + O_SS3)};
      run_gemm(lds, SEG + 3 * SEGE, (const u16*)(ws + O_WT_CO), GT, DM, 512, E);
    } break;
    case 11: {
      EpiSwiglu E{SEG + 4 * SEGE, (const float*)(ws + O_SS3)};
      run_gemm(lds, XB, (const u16*)(ws + O_WT_FI), GT, 2 * DFF, DM, E);
    } break;
    case 12: {
      EpiResid E{xout, sel == 3 ? (float*)(ws + O_OP) : xout};
      run_gemm(lds, SEG + 4 * SEGE, (const u16*)(ws + O_WT_FO), GT, DM, DFF, E);
    } break;
    case 13: {
      {
        const int step = gridDim.x * 8;
        for (int r = blockIdx.x * 8 + wid; r < GT; r += 2 * step) {
          const bool two = r + step < GT;
          float* rowa = xout + (long)r * DM; float* rowb = xout + (long)(two ? r + step : r) * DM;
          float* wa_ = sel == 3 ? (float*)(ws + O_OP) + (long)r * DM : rowa; float* wb_ = sel == 3 ? (float*)(ws + O_OP) + (long)(r + step) * DM : rowb;
          f32x4 va[8], vb[8], gg[8]; float ssa = 0.f, ssb = 0.f;
#pragma unroll
          for (int i = 0; i < 8; ++i) { va[i] = *reinterpret_cast<const f32x4*>(rowa + lane * 4 + 256 * i); vb[i] = *reinterpret_cast<const f32x4*>(rowb + lane * 4 + 256 * i);
            gg[i] = *reinterpret_cast<const f32x4*>(p.norm_final_g + lane * 4 + 256 * i); }
#pragma unroll
          for (int i = 0; i < 8; ++i) { ssa += va[i][0] * va[i][0] + va[i][1] * va[i][1] + va[i][2] * va[i][2] + va[i][3] * va[i][3]; ssb += vb[i][0] * vb[i][0] + vb[i][1] * vb[i][1] + vb[i][2] * vb[i][2] + vb[i][3] * vb[i][3]; }
          ssa = wave_sum(ssa); ssb = wave_sum(ssb);
          const float ra = rsqrtf(ssa * (1.f / 2048.f) + 1e-6f), rb = rsqrtf(ssb * (1.f / 2048.f) + 1e-6f);
#pragma unroll
          for (int i = 0; i < 8; ++i) {
            *reinterpret_cast<f32x4*>(wa_ + lane * 4 + 256 * i) = va[i] * gg[i] * ra;
            if (two) *reinterpret_cast<f32x4*>(wb_ + lane * 4 + 256 * i) = vb[i] * gg[i] * rb;
          }
        }
      }
    } break;
    default: break;
  }
}

#define XB_TMO      128
#define XB_XCNT(j)  (256  + 64 * (j))
#define XB_XSUB(j)  (1280 + 64 * (j))
#define XB_XGEN(j)  (2304 + 64 * (j))
#define XB_TOP      3328
#define XB_TOPGEN   3392
#define XCD_BAR_WORDS 3456
#define XB_SPIN_CAP (1u << 18)
DI unsigned xb_ld(unsigned* p)              { return __hip_atomic_load(p, __ATOMIC_RELAXED, __HIP_MEMORY_SCOPE_AGENT); }
DI unsigned xb_add(unsigned* p, unsigned v) { return __hip_atomic_fetch_add(p, v, __ATOMIC_RELAXED, __HIP_MEMORY_SCOPE_AGENT); }
DI unsigned xb_xcc_id() { return (unsigned)__builtin_amdgcn_s_getreg((3 << 11) | 20) & 0xFu; }
#define XB_SPIN(cond, bar) do { unsigned _sp = 0; while (cond) { __builtin_amdgcn_s_sleep(1); \
    if ((++_sp & 255u) == 0u) { if (xb_ld(&(bar)[XB_TMO])) break; if (_sp > XB_SPIN_CAP) { atomicAdd(&(bar)[XB_TMO], 1u); break; } } } } while (0)
struct XcdBarrier { unsigned* bar; unsigned x; volatile PG8_LAS unsigned* st; };
DI XcdBarrier xcd_barrier_post(unsigned* bar, volatile PG8_LAS unsigned* st) {
  XcdBarrier b; b.bar = bar; b.x = xb_xcc_id(); b.st = st;
  if (threadIdx.x == 0) (void)xb_add(&bar[XB_XCNT(b.x)], 1u);
  return b;
}
DI void xcd_barrier_complete(unsigned* bar, unsigned x, unsigned& nloc, unsigned& nx) {
  const unsigned G = gridDim.x * gridDim.y * gridDim.z;
  unsigned sum, cnt, mine, sp = 0u;
  for (;;) {
    sum = 0u; cnt = 0u; mine = 0u;
#pragma unroll
    for (unsigned j = 0; j < 16; ++j) { const unsigned c = xb_ld(&bar[XB_XCNT(j)]); sum += c; cnt += (c > 0u) ? 1u : 0u; mine = (j == x) ? c : mine; }
    if (sum == G) break;
    __builtin_amdgcn_s_sleep(1);
    if ((++sp & 255u) == 0u) { if (xb_ld(&bar[XB_TMO])) break; if (sp > XB_SPIN_CAP) { atomicAdd(&bar[XB_TMO], 1u); break; } }
  }
  nloc = mine > 0u ? mine : 1u; nx = cnt > 0u ? cnt : 1u;
}
DI void xcd_barrier(const XcdBarrier& b) {
  asm volatile("s_waitcnt vmcnt(0)" ::: "memory");
  __syncthreads();
  if (threadIdx.x == 0) {
    unsigned* bar = b.bar;
    __builtin_amdgcn_s_waitcnt(0);
    unsigned nloc = b.st[0], nx = b.st[1];
    if (nloc == 0u) { xcd_barrier_complete(bar, b.x, nloc, nx); b.st[0] = nloc; b.st[1] = nx; }
    const unsigned old = xb_add(&bar[XB_XSUB(b.x)], 1u);
    const unsigned gen = old / nloc;
    if (old + 1u == (gen + 1u) * nloc) {
      __builtin_amdgcn_fence(__ATOMIC_RELEASE, "agent");
      asm volatile("s_waitcnt vmcnt(0)" ::: "memory");
      const unsigned og = xb_add(&bar[XB_TOP], 1u);
      const unsigned tg = og / nx;
      if (og + 1u == (tg + 1u) * nx) xb_add(&bar[XB_TOPGEN], 1u);
      else XB_SPIN(xb_ld(&bar[XB_TOPGEN]) == tg, bar);
      __builtin_amdgcn_fence(__ATOMIC_ACQUIRE, "agent");
      xb_add(&bar[XB_XGEN(b.x)], 1u);
      asm volatile("s_waitcnt vmcnt(0)" ::: "memory");
    } else {
      XB_SPIN(xb_ld(&bar[XB_XGEN(b.x)]) == gen, bar);
      __builtin_amdgcn_fence(__ATOMIC_ACQUIRE, "agent");
      asm volatile("s_waitcnt vmcnt(0)" ::: "memory");
    }
  }
  __syncthreads();
}

constexpr int NPHASES = 2 + 11 * NGROUP;

__global__ void __launch_bounds__(NT_THREADS) k_mega(Params p) {
  extern __shared__ __attribute__((aligned(16))) char lds[];
  __shared__ uint4 xb_words;
  cg::grid_group grid = cg::this_grid();
  if (threadIdx.x == 0) xb_words = make_uint4(0u, 0u, 0u, 0u);
  __syncthreads();
  const XcdBarrier xb = xcd_barrier_post((unsigned*)(p.ws + O_BAR), (volatile PG8_LAS unsigned*)&xb_words);
#pragma unroll 1
  for (int ph = 0; ph < NPHASES; ++ph) {
    run_phase(p, ph, lds);
    if (DUP_MASK && ph >= 2 && ((DUP_MASK >> ((ph - 2) % 11)) & 1)) { grid.sync(); run_phase(p, ph, lds, DUP_SEL); }
    if ((DUP_MASK & 0x8000) && ph == 0) { for (int rep = 0; rep < 3; ++rep) { grid.sync(); run_phase(p, ph, lds, DUP_SEL); } }
    if (ph + 1 < NPHASES) { if (ph == 0) grid.sync(); else xcd_barrier(xb); }
  }
}
#if !MEGA
__global__ void __launch_bounds__(NT_THREADS) k_phase(Params p, int ph) {
  extern __shared__ __attribute__((aligned(16))) char lds[];
  run_phase(p, ph, lds);
}
#endif

extern "C" void kernel_launch(void* const* d_in, const int* in_sizes, int n_in, void* d_out, int out_size, void* d_ws, size_t ws_size, hipStream_t stream) {
  static int grid_blocks = 0;
  if (!grid_blocks) {
    if (ws_size < O_END) { fprintf(stderr, "kernel_launch: workspace too small: %zu < %zu\n", ws_size, (size_t)O_END); return; }
    (void)hipFuncSetAttribute((const void*)k_mega, hipFuncAttributeMaxDynamicSharedMemorySize, LDS_BYTES);
#if !MEGA
    (void)hipFuncSetAttribute((const void*)k_phase, hipFuncAttributeMaxDynamicSharedMemorySize, LDS_BYTES);
#endif
    int dev = 0, cus = 0, per_cu = 0;
    (void)hipGetDevice(&dev);
    (void)hipDeviceGetAttribute(&cus, hipDeviceAttributeMultiprocessorCount, dev);
    (void)hipOccupancyMaxActiveBlocksPerMultiprocessor(&per_cu, k_mega, NT_THREADS, LDS_BYTES);
    if (per_cu < 1) per_cu = 1;
    grid_blocks = cus * per_cu;
    if (grid_blocks > 256) grid_blocks = 256;
  }
  Params p{};
  const float** pp = reinterpret_cast<const float**>(&p);
  for (int i = 0; i < 29; ++i) pp[i] = (const float*)d_in[i];
  p.out = (float*)d_out; p.ws = (char*)d_ws;
#if MEGA
  (void)hipMemsetAsync((char*)d_ws + O_BAR, 0, XCD_BAR_WORDS * 4, stream);
  void* args[] = {&p};
  hipError_t e = hipLaunchCooperativeKernel((void*)k_mega, dim3(grid_blocks), dim3(NT_THREADS), args, LDS_BYTES, stream);
  if (e != hipSuccess) fprintf(stderr, "cooperative launch failed: %s (grid %d)\n", hipGetErrorString(e), grid_blocks);
#else
  for (int ph = 0; ph < NPHASES; ++ph) hipLaunchKernelGGL(k_phase, dim3(256), dim3(NT_THREADS), LDS_BYTES, stream, p, ph);
#endif
}
```

```cpp
#include <hip/hip_runtime.h>
#include <hip/hip_bf16.h>
#include <hip/hip_cooperative_groups.h>
#include <cstdio>
#include <cstdint>
namespace cg = cooperative_groups;

#ifndef MEGA
#define MEGA 1
#endif
#ifndef PH_MASK
#define PH_MASK 0xFFFF
#endif
#ifndef DUP_MASK
#define DUP_SEL 3
#ifndef ATT_PROBE
#define ATT_PROBE 0
#endif
#define DUP_MASK 0
#endif

typedef unsigned short u16;
using bf16x8 = __attribute__((ext_vector_type(8))) short;
using s16x4  = __attribute__((ext_vector_type(4))) short;
using f32x16 = __attribute__((ext_vector_type(16))) float;
using f32x4  = __attribute__((ext_vector_type(4))) float;
using u32x4  = __attribute__((ext_vector_type(4))) unsigned;
using u32x2  = __attribute__((ext_vector_type(2))) unsigned;

#define DI __device__ __forceinline__
#define SBAR() __builtin_amdgcn_sched_barrier(0)
#define VMWAIT0() __builtin_amdgcn_s_waitcnt(0x0F70)

constexpr int DM = 2048;
constexpr int GT = 16384;
constexpr int NGROUP = 4;
constexpr int NIN = 14336;
constexpr int DFF = 5632;
constexpr int NMEMROWS = 1536;
constexpr int NT_THREADS = 512;
constexpr float LOG2E = 1.4426950408889634f;

constexpr size_t SEGSZ   = (size_t)GT * DM * 2;
constexpr size_t O_WT_IN = 0;
constexpr size_t O_WT_PA = O_WT_IN + (size_t)NIN * DM * 2;
constexpr size_t O_WT_PB = O_WT_PA + (size_t)DM * DM * 2;
constexpr size_t O_WT_OUT= O_WT_PB + (size_t)DM * DM * 2;
constexpr size_t O_WT_CQ = O_WT_OUT + (size_t)DM * DM * 2;
constexpr size_t O_WT_CKV= O_WT_CQ + (size_t)512 * DM * 2;
constexpr size_t O_WT_CO = O_WT_CKV + (size_t)1024 * DM * 2;
constexpr size_t O_WT_FI = O_WT_CO + (size_t)DM * 512 * 2;
constexpr size_t O_WT_FO = O_WT_FI + (size_t)2 * DFF * DM * 2;
constexpr size_t O_MEMB  = O_WT_FO + (size_t)DM * DFF * 2;
constexpr size_t O_MEMRS = O_MEMB + (size_t)NMEMROWS * DM * 2;
constexpr size_t O_MEMKV = O_MEMRS + 8192;
constexpr size_t O_BTAB  = O_MEMKV + (size_t)NMEMROWS * 1024 * 2;
constexpr size_t O_RSTD  = O_BTAB + 16384;
constexpr size_t O_XB    = O_RSTD + (size_t)GT * 4;
constexpr size_t O_SEG   = O_XB + SEGSZ;
constexpr size_t O_OP    = O_SEG + 7 * SEGSZ;
constexpr size_t O_LNST  = O_OP + 2 * SEGSZ;
constexpr size_t O_SS2   = O_LNST + (size_t)GT * 8;
constexpr size_t O_SS3   = O_SS2 + (size_t)GT * 4;
constexpr size_t O_BAR   = O_SS3 + (size_t)GT * 4;
constexpr size_t O_END   = O_BAR + 16384;

struct Params {
  const float *x_prompt, *x_sample, *mem_prompt, *mem_sample, *rel_table, *norm_mix_g, *w_in, *ln_v_g, *ln_v_b,
      *w_spatial, *b_spatial, *lq1, *lk1, *lq2, *lk2, *subln_g, *w_pa, *w_pb, *w_out, *norm_cross_g, *norm_mem_g,
      *w_cq, *w_ck, *w_cv, *w_co, *norm_ffn_g, *w_fi, *w_fo, *norm_final_g;
  float* out;
  char* ws;
};

DI int otid() { int t = threadIdx.x; asm volatile("" : "+v"(t)); return t; }
DI int crow(int r, int hi) { return (r & 3) + 8 * (r >> 2) + 4 * hi; }
DI unsigned cvtpk(float lo, float hi) { unsigned r; asm volatile("v_cvt_pk_bf16_f32 %0, %1, %2" : "=v"(r) : "v"(lo), "v"(hi)); return r; }
DI u16 f2bf(float x) { return (u16)(cvtpk(x, x) & 0xffffu); }
DI float bf2f(u16 v) { return __uint_as_float(((unsigned)v) << 16); }
DI float bflo(unsigned w) { return __uint_as_float(w << 16); }
DI float bfhi(unsigned w) { return __uint_as_float(w & 0xffff0000u); }
DI bf16x8 ld8(const u16* p) { return *reinterpret_cast<const bf16x8*>(p); }
DI float gelu_tanh(float x) {
  float y = 0.7978845608028654f * (x + 0.044715f * x * x * x);
  float t = __builtin_amdgcn_exp2f(y * (2.f * LOG2E));
  float th = 1.f - 2.f * __builtin_amdgcn_rcpf(t + 1.f);
  return 0.5f * x * (1.f + th);
}
DI float sigmoidf_(float x) { return 1.f - __builtin_amdgcn_rcpf(1.f + __builtin_amdgcn_exp2f(x * LOG2E)); }
DI float wave_sum(float v) {
#pragma unroll
  for (int o = 32; o > 0; o >>= 1) v += __shfl_xor(v, o, 64);
  return v;
}
DI int t5_bucket(int rel) {
  int n = rel < 0 ? -rel : rel;
  int b;
  if (n < 8) b = n;
  else if (n >= 128) b = 15;
  else { int l2 = 31 - __clz(n * n); b = 8 + (l2 - 6); if (b > 15) b = 15; }
  return b + (rel > 0 ? 16 : 0);
}

DI bool tile_map(int vb, int nrt, int nct, int CR, int CC, int& rt, int& ct) {
  if (CR == 0) { if (vb >= nrt * nct) return false; rt = vb % nrt; ct = vb / nrt; return true; }
  const int it = vb >> 8, b = vb & 255, xcd = b & 7, j = b >> 3;
  const int c = it * 8 + xcd, ncr = nrt / CR, nchunks = ncr * (nct / CC);
  if (c >= nchunks) return false;
  rt = (c % ncr) * CR + (j % CR); ct = (c / ncr) * CC + (j / CR);
  return true;
}
DI int tile_vb_end(int nrt, int nct, int CR) { return CR == 0 ? nrt * nct : ((nrt * nct / 32 + 7) / 8) * 256; }

constexpr int LROW = 144;
constexpr int LTILE = 256 * LROW;
constexpr int LDS_BYTES = 4 * LTILE;

DI void gemm_loop(f32x16 (&acc)[4][2], const u16* __restrict__ A, long lda, const u16* __restrict__ Bt, long ldb, int K, char* lds) {
  const int tid = otid(), lane = tid & 63, wid = tid >> 6, r32 = lane & 31, hi = lane >> 5, wm = wid >> 2, wn = wid & 3;
  const u16* ga = A + (long)(tid >> 3) * lda + (tid & 7) * 8;
  const u16* gb = Bt + (long)(tid >> 3) * ldb + (tid & 7) * 8;
  const int soff = (tid >> 3) * LROW + (tid & 7) * 16;
  bf16x8 ra[4], rb[4];
#pragma unroll
  for (int i = 0; i < 4; ++i) { ra[i] = ld8(ga + (long)i * 64 * lda); rb[i] = ld8(gb + (long)i * 64 * ldb); }
  __syncthreads();
#pragma unroll
  for (int i = 0; i < 4; ++i) {
    *reinterpret_cast<bf16x8*>(lds + soff + i * 64 * LROW) = ra[i];
    *reinterpret_cast<bf16x8*>(lds + LTILE + soff + i * 64 * LROW) = rb[i];
  }
  __syncthreads();
  const int nt = K >> 6;
  const int aoff = (wm * 128 + r32) * LROW + hi * 16, boff = LTILE + (wn * 64 + r32) * LROW + hi * 16;
  for (int t = 0; t < nt; ++t) {
    const char* cur = lds + (t & 1) * 2 * LTILE;
    if (t + 1 < nt) {
      const int k0 = (t + 1) * 64;
#pragma unroll
      for (int i = 0; i < 4; ++i) { ra[i] = ld8(ga + (long)i * 64 * lda + k0); rb[i] = ld8(gb + (long)i * 64 * ldb + k0); }
    }
#pragma unroll
    for (int ks = 0; ks < 4; ++ks) {
      bf16x8 a[4], b[2];
#pragma unroll
      for (int mi = 0; mi < 4; ++mi) a[mi] = *reinterpret_cast<const bf16x8*>(cur + aoff + mi * 32 * LROW + ks * 32);
#pragma unroll
      for (int ni = 0; ni < 2; ++ni) b[ni] = *reinterpret_cast<const bf16x8*>(cur + boff + ni * 32 * LROW + ks * 32);
#pragma unroll
      for (int mi = 0; mi < 4; ++mi)
#pragma unroll
        for (int ni = 0; ni < 2; ++ni) acc[mi][ni] = __builtin_amdgcn_mfma_f32_32x32x16_bf16(a[mi], b[ni], acc[mi][ni], 0, 0, 0);
    }
    if (t + 1 < nt) {
      char* nxt = lds + ((t + 1) & 1) * 2 * LTILE;
#pragma unroll
      for (int i = 0; i < 4; ++i) {
        *reinterpret_cast<bf16x8*>(nxt + soff + i * 64 * LROW) = ra[i];
        *reinterpret_cast<bf16x8*>(nxt + LTILE + soff + i * 64 * LROW) = rb[i];
      }
    }
    __syncthreads();
  }
}
DI void acc_zero(f32x16 (&acc)[4][2]) {
#pragma unroll
  for (int mi = 0; mi < 4; ++mi)
#pragma unroll
    for (int ni = 0; ni < 2; ++ni)
#pragma unroll
      for (int i = 0; i < 16; ++i) acc[mi][ni][i] = 0.f;
}
#define EPI_FOR(...)                                                                               \
  {                                                                                                \
    int tid_ = otid();                                                                              \
    const int lane_ = tid_ & 63, wid_ = tid_ >> 6, r32_ = lane_ & 31, hi_ = lane_ >> 5;             \
    const int wm_ = wid_ >> 2, wn_ = wid_ & 3;                                                     \
    _Pragma("unroll") for (int mi = 0; mi < 4; ++mi) _Pragma("unroll") for (int i = 0; i < 16; ++i) { \
      const int lrow = wm_ * 128 + mi * 32 + crow(i, hi_);                                         \
      _Pragma("unroll") for (int ni = 0; ni < 2; ++ni) {                                           \
        const int lcol = wn_ * 64 + ni * 32 + r32_;                                                \
        const float v = acc[mi][ni][i];                                                            \
        __VA_ARGS__                                                                                \
      }                                                                                            \
    }                                                                                              \
  }

namespace pg8 {
#define PG8_LAS __attribute__((address_space(3)))
constexpr int BM = 256, BK = 64, HALF = 128, HTB = HALF * BK * 2, STAGE_BYTES = 8 * HTB, NXCD = 8, WGM = 8;
DI int lds_byte(int r, int c) { const int st = (r >> 4) * 2 + (c >> 5), rr = r & 15, cc = c & 31, ob = rr * 64 + cc * 2; return st * 1024 + (ob ^ (((ob >> 9) & 1) << 5)); }
DI void stage_rc(int b, int& R, int& C) { const int st = b / 1024, sb = b % 1024, swz = sb ^ (((sb >> 9) & 1) << 5); R = (st >> 1) * 16 + swz / 64; C = (st & 1) * 32 + (swz % 64) / 2; }
DI int perm32(int rho) { const int n = rho >> 4, i = rho & 15; return 8 * (i >> 2) + 4 * n + (i & 3); }
struct Unit { int pm, pn; };
struct Gemm { const u16* A; const u16* Bt; int M, N, K; };
struct StaticOrder {
  int nM, nN, nwg, G, c;
  DI void init(int M, int N, int G_, int c_) { nM = M / BM; nN = N / BM; nwg = nM * nN; G = G_; c = c_; }
  DI bool next(int i, Unit& u) const {
    const long L = (long)i * G + c; if (L >= nwg) return false;
    int wgid = (int)L; { const int q = nwg / NXCD, r = nwg % NXCD, xcd = wgid % NXCD, off = wgid / NXCD; wgid = (xcd < r ? xcd * (q + 1) : r * (q + 1) + (xcd - r) * q) + off; }
    const int nig = WGM * nN, gid = wgid / nig, fm = gid * WGM, gsz = (nM - fm) < WGM ? (nM - fm) : WGM;
    u.pm = fm + ((wgid % nig) % gsz); u.pn = (wgid % nig) / gsz; return true;
  }
};
template <class Epi>
DI void gemm_phase(PG8_LAS unsigned char* lds, const Gemm g, const StaticOrder& S, const Epi& E) {
  const int tid = otid(), wid = __builtin_amdgcn_readfirstlane(tid >> 6), lane = tid & 63, wr = wid >> 2, wc = wid & 3, fr = lane & 15, fq = lane >> 4;
  const int K = g.K, nt = K / BK;
  unsigned voffA[2], voffB[2];
#pragma unroll
  for (int i = 0; i < 2; ++i) { int R, C; stage_rc(tid * 16 + i * 8192, R, C); const int Rb = (R & ~31) + perm32(R & 31);
    voffA[i] = (unsigned)(R * K + C) * 2u; voffB[i] = (unsigned)(Rb * K + C) * 2u; }
  const size_t kstep = (size_t)(BK * 2);
  const size_t hstep = (size_t)HALF * K * 2;
  const size_t tstep = 2 * hstep;
  const unsigned ldsw = (unsigned)wid * 1024u;
  const int aoff = lds_byte(wr * 64 + fr, fq * 8), boff = lds_byte(wc * 32 + fr, fq * 8);
#define PG8_SA(b, h) (((b) * 2 + (h)) * HTB)
#define PG8_SB(b, h) ((4 + (b) * 2 + (h)) * HTB)
#define PG8_STAGE(bufoff, gbase, voff) do { _Pragma("unroll") for (int _i = 0; _i < 2; ++_i) \
    __builtin_amdgcn_global_load_lds((const unsigned*)((const char*)(gbase) + (voff)[_i]), (PG8_LAS unsigned*)(lds + (bufoff) + ldsw + _i * 8192), 16, 0, 0); } while (0)
#define PG8_LDA(dst, b, h) do { _Pragma("unroll") for (int m = 0; m < 4; ++m) _Pragma("unroll") for (int k = 0; k < 2; ++k) dst[m][k] = *(const PG8_LAS bf16x8*)(lds + PG8_SA(b, h) + aoff + m * 2048 + k * 1024); } while (0)
#define PG8_LDB(dst, b, h) do { _Pragma("unroll") for (int n = 0; n < 2; ++n) _Pragma("unroll") for (int k = 0; k < 2; ++k) dst[n][k] = *(const PG8_LAS bf16x8*)(lds + PG8_SB(b, h) + boff + n * 2048 + k * 1024); } while (0)
#define PG8_MMA(ai, bj, At, Bt) do { __builtin_amdgcn_s_setprio(1); _Pragma("unroll") for (int m = 0; m < 4; ++m) _Pragma("unroll") for (int n = 0; n < 2; ++n) _Pragma("unroll") for (int k = 0; k < 2; ++k) \
    acc[ai][bj][m][n] = __builtin_amdgcn_mfma_f32_16x16x32_bf16(Bt[n][k], At[m][k], acc[ai][bj][m][n], 0, 0, 0); __builtin_amdgcn_s_setprio(0); } while (0)
#define PG8_WAIT_V(n) asm volatile("s_waitcnt vmcnt(" #n ")" ::: "memory")
#define PG8_WAIT_L(n) asm volatile("s_waitcnt lgkmcnt(" #n ")" ::: "memory")
#define PG8_BAR __builtin_amdgcn_s_barrier()
#define PG8_SCHED __builtin_amdgcn_sched_barrier(0)
  Unit cur, nxt; int ui = 0;
  if (!S.next(0, cur)) return;
  f32x4 acc[2][2][4][2];
#pragma unroll
  for (int a = 0; a < 2; ++a)
#pragma unroll
    for (int b = 0; b < 2; ++b)
#pragma unroll
      for (int m = 0; m < 4; ++m)
#pragma unroll
        for (int n = 0; n < 2; ++n) acc[a][b][m][n] = (f32x4){0.f, 0.f, 0.f, 0.f};
  bf16x8 At[4][2], B0[2][2], B1[2][2];
  const char* cA = (const char*)g.A + (size_t)cur.pm * tstep; const char* cB = (const char*)g.Bt + (size_t)cur.pn * tstep;
  PG8_STAGE(PG8_SB(0, 0), cB, voffB); PG8_STAGE(PG8_SA(0, 0), cA, voffA); PG8_STAGE(PG8_SB(0, 1), cB + hstep, voffB); PG8_STAGE(PG8_SA(0, 1), cA + hstep, voffA);
  if (wr == 1) PG8_BAR;
  PG8_WAIT_V(4); PG8_BAR;
  PG8_STAGE(PG8_SB(1, 0), cB + kstep, voffB); PG8_STAGE(PG8_SA(1, 0), cA + kstep, voffA); PG8_STAGE(PG8_SB(1, 1), cB + hstep + kstep, voffB);
  PG8_WAIT_V(6); PG8_BAR;
  for (;;) {
    const bool has_next = S.next(ui + 1, nxt);
    const char* nA = has_next ? (const char*)g.A + (size_t)nxt.pm * tstep : cA; const char* nB = has_next ? (const char*)g.Bt + (size_t)nxt.pn * tstep : cB;
    for (int t = 0; t < nt; t += 2) {
      const bool last = (t == nt - 2);
      const char* a1 = cA + (size_t)(t + 1) * kstep;
      const char* a2 = last ? nA : cA + (size_t)(t + 2) * kstep; const char* b2 = last ? nB : cB + (size_t)(t + 2) * kstep;
      const char* a3 = a2 + kstep; const char* b3 = b2 + kstep;
      PG8_LDB(B0, 0, 0); PG8_SCHED; PG8_LDA(At, 0, 0); PG8_STAGE(PG8_SA(1, 1), a1 + hstep, voffA);
      PG8_WAIT_L(8); PG8_BAR; PG8_WAIT_L(0); PG8_MMA(0, 0, At, B0); PG8_BAR; PG8_SCHED;
      PG8_LDB(B1, 0, 1); PG8_STAGE(PG8_SB(0, 0), b2, voffB);
      PG8_BAR; PG8_WAIT_L(0); PG8_MMA(0, 1, At, B1); PG8_BAR;
      PG8_LDA(At, 0, 1); PG8_STAGE(PG8_SA(0, 0), a2, voffA);
      PG8_BAR; PG8_WAIT_L(0); PG8_MMA(1, 0, At, B0); PG8_BAR; PG8_SCHED;
      PG8_STAGE(PG8_SB(0, 1), b2 + hstep, voffB);
      PG8_WAIT_V(6); PG8_BAR; PG8_MMA(1, 1, At, B1); PG8_BAR;
      PG8_LDB(B0, 1, 0); PG8_SCHED; PG8_LDA(At, 1, 0); PG8_STAGE(PG8_SA(0, 1), a2 + hstep, voffA);
      PG8_WAIT_L(8); PG8_BAR; PG8_WAIT_L(0); PG8_MMA(0, 0, At, B0); PG8_BAR; PG8_SCHED;
      PG8_LDB(B1, 1, 1); PG8_STAGE(PG8_SB(1, 0), b3, voffB);
      PG8_BAR; PG8_WAIT_L(0); PG8_MMA(0, 1, At, B1); PG8_BAR;
      PG8_LDA(At, 1, 1); PG8_STAGE(PG8_SA(1, 0), a3, voffA);
      PG8_BAR; PG8_WAIT_L(0); PG8_MMA(1, 0, At, B0); PG8_BAR; PG8_SCHED;
      PG8_STAGE(PG8_SB(1, 1), b3 + hstep, voffB);
      PG8_WAIT_V(6); PG8_BAR; PG8_MMA(1, 1, At, B1); PG8_BAR;
    }
    E(acc, cur, wr, wc, fr, fq);
    if (!has_next) break;
#pragma unroll
    for (int a = 0; a < 2; ++a)
#pragma unroll
      for (int b = 0; b < 2; ++b)
#pragma unroll
        for (int m = 0; m < 4; ++m)
#pragma unroll
          for (int n = 0; n < 2; ++n) acc[a][b][m][n] = (f32x4){0.f, 0.f, 0.f, 0.f};
    cur = nxt; cA = nA; cB = nB; ++ui;
  }
  PG8_WAIT_V(0);
  if (wr == 0) PG8_BAR;
  PG8_BAR;
#undef PG8_SA
#undef PG8_SB
#undef PG8_STAGE
#undef PG8_LDA
#undef PG8_LDB
#undef PG8_MMA
#undef PG8_WAIT_V
#undef PG8_WAIT_L
#undef PG8_BAR
#undef PG8_SCHED
}
}
using pg8::Unit;
typedef const f32x4 (&AccRef)[2][2][4][2];
constexpr long SEGE_ = (long)GT * DM;
DI u32x4 pack8(f32x4 a, f32x4 b) { u32x4 w = {cvtpk(a[0], a[1]), cvtpk(a[2], a[3]), cvtpk(b[0], b[1]), cvtpk(b[2], b[3])}; return w; }
DI f32x4 bf4lo(u32x4 w) { f32x4 r = {bflo(w[0]), bfhi(w[0]), bflo(w[1]), bfhi(w[1])}; return r; }
DI f32x4 bf4hi(u32x4 w) { f32x4 r = {bflo(w[2]), bfhi(w[2]), bflo(w[3]), bfhi(w[3])}; return r; }
#define EPI8_FOR(...)                                                                                     \
  _Pragma("unroll") for (int ai = 0; ai < 2; ++ai) _Pragma("unroll") for (int m = 0; m < 4; ++m) {        \
    const int ROW = u.pm * 256 + ai * 128 + wr * 64 + m * 16 + fr;                                        \
    _Pragma("unroll") for (int bj = 0; bj < 2; ++bj) {                                                    \
      const int LCOL = bj * 128 + wc * 32 + 8 * fq;                                                       \
      f32x4 v0 = acc[ai][bj][m][0], v1 = acc[ai][bj][m][1];                                               \
      __VA_ARGS__                                                                                         \
    }                                                                                                     \
  }
struct EpiInproj {
  u16* seg; const float* rstd; float* lnacc; unsigned* kmax; int slen;
  DI void operator()(AccRef acc, const Unit& u, int wr, int wc, int fr, int fq) const {
    const int sg = u.pn >> 3; u16* base = seg + sg * SEGE_ + (u.pn & 7) * 256;
    float rs8[2][4];
#pragma unroll
    for (int ai = 0; ai < 2; ++ai)
#pragma unroll
      for (int m = 0; m < 4; ++m) rs8[ai][m] = 1.f;
    if (sg == 0) {
      EPI8_FOR({ const float rs = rs8[ai][m];
        _Pragma("unroll") for (int e = 0; e < 4; ++e) { v0[e] = gelu_tanh(v0[e] * rs); v1[e] = gelu_tanh(v1[e] * rs); }
        *reinterpret_cast<u32x4*>(base + (long)ROW * DM + LCOL) = pack8(v0, v1); })
    } else if (sg == 1) {
#pragma unroll
      for (int ai = 0; ai < 2; ++ai)
#pragma unroll
        for (int m = 0; m < 4; ++m) {
          const int ROW = u.pm * 256 + ai * 128 + wr * 64 + m * 16 + fr; const float rs = rs8[ai][m]; float s1 = 0.f, s2 = 0.f;
#pragma unroll
          for (int bj = 0; bj < 2; ++bj) {
            f32x4 v0 = acc[ai][bj][m][0], v1 = acc[ai][bj][m][1];
#pragma unroll
            for (int e = 0; e < 4; ++e) { v0[e] = gelu_tanh(v0[e] * rs); v1[e] = gelu_tanh(v1[e] * rs); }
            const u32x4 w = pack8(v0, v1);
            *reinterpret_cast<u32x4*>(base + (long)ROW * DM + bj * 128 + wc * 32 + 8 * fq) = w;
            const f32x4 r0 = bf4lo(w), r1 = bf4hi(w);
#pragma unroll
            for (int e = 0; e < 4; ++e) { s1 += r0[e] + r1[e]; s2 = fmaf(r0[e], r0[e], fmaf(r1[e], r1[e], s2)); }
          }
          s1 += __shfl_xor(s1, 16, 64); s1 += __shfl_xor(s1, 32, 64); s2 += __shfl_xor(s2, 16, 64); s2 += __shfl_xor(s2, 32, 64);
          if (fq == 0) { atomicAdd(lnacc + 2 * ROW, s1); atomicAdd(lnacc + 2 * ROW + 1, s2); }
        }
    } else if (sg == 3) {
      float mx0 = 0.f, mx1 = 0.f;
#pragma unroll
      for (int ai = 0; ai < 2; ++ai)
#pragma unroll
        for (int m = 0; m < 4; ++m) {
          const int ROW = u.pm * 256 + ai * 128 + wr * 64 + m * 16 + fr; const float rs = rs8[ai][m];
#pragma unroll
          for (int bj = 0; bj < 2; ++bj) {
            const u32x4 w = pack8(acc[ai][bj][m][0] * rs, acc[ai][bj][m][1] * rs);
            *reinterpret_cast<u32x4*>(base + (long)ROW * DM + bj * 128 + wc * 32 + 8 * fq) = w;
            const f32x4 r0 = bf4lo(w), r1 = bf4hi(w); float pp = 0.f;
#pragma unroll
            for (int e = 0; e < 4; ++e) pp = fmaf(r0[e], r0[e], fmaf(r1[e], r1[e], pp));
            pp += __shfl_xor(pp, 16, 64); pp += __shfl_xor(pp, 32, 64);
            if (bj == 0) mx0 = fmaxf(mx0, pp); else mx1 = fmaxf(mx1, pp);
          }
        }
#pragma unroll
      for (int o = 1; o < 16; o <<= 1) { mx0 = fmaxf(mx0, __shfl_xor(mx0, o, 64)); mx1 = fmaxf(mx1, __shfl_xor(mx1, o, 64)); }
      if ((threadIdx.x & 63) == 0) {
        const int sq = (u.pm * 256 >= slen) ? 1 : 0, hm = (u.pn & 7) * 2;
        atomicMax(kmax + sq * 16 + hm, __float_as_uint(4.f * mx0)); atomicMax(kmax + sq * 16 + hm + 1, __float_as_uint(4.f * mx1));
      }
    } else if (sg < 5) {
      EPI8_FOR({ const float rs = rs8[ai][m]; *reinterpret_cast<u32x4*>(base + (long)ROW * DM + LCOL) = pack8(v0 * rs, v1 * rs); })
    } else {
      EPI8_FOR({ const float rs = rs8[ai][m];
        _Pragma("unroll") for (int e = 0; e < 4; ++e) { v0[e] = sigmoidf_(v0[e] * rs); v1[e] = sigmoidf_(v1[e] * rs); }
        *reinterpret_cast<u32x4*>(base + (long)ROW * DM + LCOL) = pack8(v0, v1); })
    }
  }
};
struct EpiScaleBf16 {
  u16* dst; int ldc; const float* rstd; const float* ss;
  DI void operator()(AccRef acc, const Unit& u, int wr, int wc, int fr, int fq) const {
    float rs8[2][4];
#pragma unroll
    for (int ai = 0; ai < 2; ++ai)
#pragma unroll
      for (int m = 0; m < 4; ++m) { const int R_ = u.pm * 256 + ai * 128 + wr * 64 + m * 16 + fr; rs8[ai][m] = ss ? ss[R_] : rstd[R_]; }
    VMWAIT0(); SBAR();
    EPI8_FOR({ const float rs = ss ? rsqrtf(rs8[ai][m] * (1.f / 2048.f) + 1e-6f) : rs8[ai][m]; *reinterpret_cast<u32x4*>(dst + (long)ROW * ldc + u.pn * 256 + LCOL) = pack8(v0 * rs, v1 * rs); })
  }
};
struct EpiMerge1 {
  float* T; const u16* GA;
  DI void operator()(AccRef acc, const Unit& u, int wr, int wc, int fr, int fq) const {
#pragma unroll
    for (int ai = 0; ai < 2; ++ai) {
      u32x4 gw[4][2];
#pragma unroll
      for (int m = 0; m < 4; ++m)
#pragma unroll
        for (int bj = 0; bj < 2; ++bj) gw[m][bj] = *reinterpret_cast<const u32x4*>(GA + (long)(u.pm * 256 + ai * 128 + wr * 64 + m * 16 + fr) * DM + u.pn * 256 + bj * 128 + wc * 32 + 8 * fq);
      VMWAIT0(); SBAR();
#pragma unroll
      for (int m = 0; m < 4; ++m)
#pragma unroll
        for (int bj = 0; bj < 2; ++bj) { const long idx = (long)(u.pm * 256 + ai * 128 + wr * 64 + m * 16 + fr) * DM + u.pn * 256 + bj * 128 + wc * 32 + 8 * fq;
          *reinterpret_cast<f32x4*>(T + idx) = acc[ai][bj][m][0] * bf4lo(gw[m][bj]); *reinterpret_cast<f32x4*>(T + idx + 4) = acc[ai][bj][m][1] * bf4hi(gw[m][bj]); }
      SBAR();
    }
  }
};
struct EpiMerge2 {
  const float* T; const u16* GB; u16* MG;
  DI void operator()(AccRef acc, const Unit& u, int wr, int wc, int fr, int fq) const {
#pragma unroll
    for (int ai = 0; ai < 2; ++ai)
#pragma unroll
      for (int mh = 0; mh < 2; ++mh) {
        u32x4 gw[2][2]; f32x4 t0[2][2], t1[2][2];
#pragma unroll
        for (int mm = 0; mm < 2; ++mm)
#pragma unroll
          for (int bj = 0; bj < 2; ++bj) { const long idx = (long)(u.pm * 256 + ai * 128 + wr * 64 + (mh * 2 + mm) * 16 + fr) * DM + u.pn * 256 + bj * 128 + wc * 32 + 8 * fq;
            gw[mm][bj] = *reinterpret_cast<const u32x4*>(GB + idx); t0[mm][bj] = *reinterpret_cast<const f32x4*>(T + idx); t1[mm][bj] = *reinterpret_cast<const f32x4*>(T + idx + 4); }
        VMWAIT0(); SBAR();
#pragma unroll
        for (int mm = 0; mm < 2; ++mm)
#pragma unroll
          for (int bj = 0; bj < 2; ++bj) { const int m = mh * 2 + mm; const long idx = (long)(u.pm * 256 + ai * 128 + wr * 64 + m * 16 + fr) * DM + u.pn * 256 + bj * 128 + wc * 32 + 8 * fq;
            *reinterpret_cast<u32x4*>(MG + idx) = pack8(t0[mm][bj] + acc[ai][bj][m][0] * bf4lo(gw[mm][bj]), t1[mm][bj] + acc[ai][bj][m][1] * bf4hi(gw[mm][bj])); }
        SBAR();
      }
  }
};
struct EpiResid {
  const float* xin; float* xout;
  DI void operator()(AccRef acc, const Unit& u, int wr, int wc, int fr, int fq) const {
#pragma unroll
    for (int ai = 0; ai < 2; ++ai) {
      f32x4 t0[4][2], t1[4][2];
#pragma unroll
      for (int m = 0; m < 4; ++m)
#pragma unroll
        for (int bj = 0; bj < 2; ++bj) { const long idx = (long)(u.pm * 256 + ai * 128 + wr * 64 + m * 16 + fr) * DM + u.pn * 256 + bj * 128 + wc * 32 + 8 * fq;
          t0[m][bj] = *reinterpret_cast<const f32x4*>(xin + idx); t1[m][bj] = *reinterpret_cast<const f32x4*>(xin + idx + 4); }
      VMWAIT0(); SBAR();
#pragma unroll
      for (int m = 0; m < 4; ++m)
#pragma unroll
        for (int bj = 0; bj < 2; ++bj) { const long idx = (long)(u.pm * 256 + ai * 128 + wr * 64 + m * 16 + fr) * DM + u.pn * 256 + bj * 128 + wc * 32 + 8 * fq;
          *reinterpret_cast<f32x4*>(xout + idx) = t0[m][bj] + acc[ai][bj][m][0]; *reinterpret_cast<f32x4*>(xout + idx + 4) = t1[m][bj] + acc[ai][bj][m][1]; }
      SBAR();
    }
  }
};
struct EpiResidNorm {
  const float* xin; float* xout; u16* xb; float* ss;
  DI void operator()(AccRef acc, const Unit& u, int wr, int wc, int fr, int fq) const {
#pragma unroll
    for (int ai = 0; ai < 2; ++ai) {
      f32x4 t0[4][2], t1[4][2];
#pragma unroll
      for (int m = 0; m < 4; ++m)
#pragma unroll
        for (int bj = 0; bj < 2; ++bj) { const long idx = (long)(u.pm * 256 + ai * 128 + wr * 64 + m * 16 + fr) * DM + u.pn * 256 + bj * 128 + wc * 32 + 8 * fq;
          t0[m][bj] = *reinterpret_cast<const f32x4*>(xin + idx); t1[m][bj] = *reinterpret_cast<const f32x4*>(xin + idx + 4); }
      VMWAIT0(); SBAR();
#pragma unroll
      for (int m = 0; m < 4; ++m) {
        const int ROW = u.pm * 256 + ai * 128 + wr * 64 + m * 16 + fr; float part = 0.f;
#pragma unroll
        for (int bj = 0; bj < 2; ++bj) {
          const long idx = (long)ROW * DM + u.pn * 256 + bj * 128 + wc * 32 + 8 * fq;
          const f32x4 y0 = t0[m][bj] + acc[ai][bj][m][0], y1 = t1[m][bj] + acc[ai][bj][m][1];
          *reinterpret_cast<f32x4*>(xout + idx) = y0; *reinterpret_cast<f32x4*>(xout + idx + 4) = y1;
          *reinterpret_cast<u32x4*>(xb + idx) = pack8(y0, y1);
#pragma unroll
          for (int e = 0; e < 4; ++e) part = fmaf(y0[e], y0[e], fmaf(y1[e], y1[e], part));
        }
        part += __shfl_xor(part, 16, 64); part += __shfl_xor(part, 32, 64);
        if (fq == 0) atomicAdd(ss + ROW, part);
      }
      SBAR();
    }
  }
};
struct EpiSwiglu {
  u16* hid; const float* ss;
  DI void operator()(AccRef acc, const Unit& u, int wr, int wc, int fr, int fq) const {
    float rs8[2][4];
#pragma unroll
    for (int ai = 0; ai < 2; ++ai)
#pragma unroll
      for (int m = 0; m < 4; ++m) rs8[ai][m] = ss[u.pm * 256 + ai * 128 + wr * 64 + m * 16 + fr];
    VMWAIT0(); SBAR();
#pragma unroll
    for (int ai = 0; ai < 2; ++ai)
#pragma unroll
      for (int m = 0; m < 4; ++m) {
        const int ROW = u.pm * 256 + ai * 128 + wr * 64 + m * 16 + fr; const float rs = rsqrtf(rs8[ai][m] * (1.f / 2048.f) + 1e-6f);
        f32x4 g0 = acc[ai][0][m][0] * rs, g1 = acc[ai][0][m][1] * rs, u0 = acc[ai][1][m][0] * rs, u1 = acc[ai][1][m][1] * rs;
#pragma unroll
        for (int e = 0; e < 4; ++e) { g0[e] = g0[e] * sigmoidf_(g0[e]) * u0[e]; g1[e] = g1[e] * sigmoidf_(g1[e]) * u1[e]; }
        *reinterpret_cast<u32x4*>(hid + (long)ROW * DFF + u.pn * 128 + wc * 32 + 8 * fq) = pack8(g0, g1);
      }
  }
};
template <class Epi> DI void run_gemm(char* lds, const u16* A, const u16* Bt, int M, int N, int K, const Epi& E) {
  extern __shared__ __attribute__((aligned(16))) unsigned char gemm_shm[];
  (void)lds;
  pg8::Gemm G{A, Bt, M, N, K}; pg8::StaticOrder S; S.init(M, N, (int)gridDim.x, (int)blockIdx.x);
  pg8::gemm_phase<Epi>((PG8_LAS unsigned char*)gemm_shm, G, S, E);
}

struct ConvJob { const float* src; const float* g; u16* dst; int N, K, perm, kt, ntile; };
struct ConvRegs { f32x4 v0, v1; float s0, s1; };
DI void conv_load(const ConvJob& J, ConvRegs& R, int tid) {
  const int k0 = J.kt * 64, n0 = J.ntile * 64, kk = tid >> 4, n4 = (tid & 15) * 4;
  R.v0 = *reinterpret_cast<const f32x4*>(J.src + (long)(k0 + kk) * J.N + n0 + n4);
  R.v1 = *reinterpret_cast<const f32x4*>(J.src + (long)(k0 + kk + 32) * J.N + n0 + n4);
  R.s0 = J.g ? J.g[k0 + kk] : 1.f; R.s1 = J.g ? J.g[k0 + kk + 32] : 1.f;
}
DI void conv_store(const ConvJob& J, const ConvRegs& R, int tid, char* lds) {
  float* tile = reinterpret_cast<float*>(lds);
  const int k0 = J.kt * 64, n0 = J.ntile * 64;
  { const int kk = tid >> 4, n4 = (tid & 15) * 4;
    tile[kk * 65 + n4 + 0] = R.v0[0] * R.s0; tile[kk * 65 + n4 + 1] = R.v0[1] * R.s0; tile[kk * 65 + n4 + 2] = R.v0[2] * R.s0; tile[kk * 65 + n4 + 3] = R.v0[3] * R.s0;
    tile[(kk + 32) * 65 + n4 + 0] = R.v1[0] * R.s1; tile[(kk + 32) * 65 + n4 + 1] = R.v1[1] * R.s1; tile[(kk + 32) * 65 + n4 + 2] = R.v1[2] * R.s1; tile[(kk + 32) * 65 + n4 + 3] = R.v1[3] * R.s1; }
  __syncthreads();
  {
    const int n = tid >> 3, k8 = (tid & 7) * 8;
    float f[8];
#pragma unroll
    for (int e = 0; e < 8; ++e) f[e] = tile[(k8 + e) * 65 + n];
    u32x4 w = {cvtpk(f[0], f[1]), cvtpk(f[2], f[3]), cvtpk(f[4], f[5]), cvtpk(f[6], f[7])};
    int nn = n0 + n;
    if (J.perm) { const int isup = nn >= DFF ? 1 : 0, jj = nn - isup * DFF; nn = 256 * (jj >> 7) + 128 * isup + (jj & 127); }
    *reinterpret_cast<u32x4*>(J.dst + (long)nn * J.K + k0 + k8) = w;
  }
  __syncthreads();
}

DI void prep_row(const float* __restrict__ src, u16* __restrict__ dstb, float* __restrict__ rstd_out, int lane) {
  f32x4 v[8]; float ss = 0.f;
#pragma unroll
  for (int i = 0; i < 8; ++i) { v[i] = *reinterpret_cast<const f32x4*>(src + lane * 4 + 256 * i); ss += v[i][0] * v[i][0] + v[i][1] * v[i][1] + v[i][2] * v[i][2] + v[i][3] * v[i][3]; }
  ss = wave_sum(ss);
#pragma unroll
  for (int i = 0; i < 8; ++i) { u32x2 w = {cvtpk(v[i][0], v[i][1]), cvtpk(v[i][2], v[i][3])}; *reinterpret_cast<u32x2*>(dstb + lane * 4 + 256 * i) = w; }
  if (lane == 0) *rstd_out = rsqrtf(ss * (1.f / 2048.f) + 1e-6f);
}

DI void phase_convert(const Params& p, char* lds) {
  char* ws = p.ws;
  const int T0 = 32 * 224, T1 = T0 + 1024, T2 = T1 + 1024, T3 = T2 + 1024, T4 = T3 + 256, T5 = T4 + 256, T6 = T5 + 256, T7 = T6 + 256, T8 = T7 + 32 * 176, T9 = T8 + 88 * 32;
  const int ctid = otid();
#define CONV_DECODE(t, J) do { int lt; J.g = nullptr; J.perm = 0; \
    if ((t) < T0)      { lt = (t);      J.src = p.w_in;  J.N = NIN;  J.K = DM;  J.dst = (u16*)(ws + O_WT_IN);  J.g = p.norm_mix_g; } \
    else if ((t) < T1) { lt = (t) - T0; J.src = p.w_pa;  J.N = DM;   J.K = DM;  J.dst = (u16*)(ws + O_WT_PA); } \
    else if ((t) < T2) { lt = (t) - T1; J.src = p.w_pb;  J.N = DM;   J.K = DM;  J.dst = (u16*)(ws + O_WT_PB); } \
    else if ((t) < T3) { lt = (t) - T2; J.src = p.w_out; J.N = DM;   J.K = DM;  J.dst = (u16*)(ws + O_WT_OUT); } \
    else if ((t) < T4) { lt = (t) - T3; J.src = p.w_cq;  J.N = 512;  J.K = DM;  J.dst = (u16*)(ws + O_WT_CQ);  J.g = p.norm_cross_g; } \
    else if ((t) < T5) { lt = (t) - T4; J.src = p.w_ck;  J.N = 512;  J.K = DM;  J.dst = (u16*)(ws + O_WT_CKV); J.g = p.norm_mem_g; } \
    else if ((t) < T6) { lt = (t) - T5; J.src = p.w_cv;  J.N = 512;  J.K = DM;  J.dst = (u16*)(ws + O_WT_CKV) + (long)512 * DM; J.g = p.norm_mem_g; } \
    else if ((t) < T7) { lt = (t) - T6; J.src = p.w_co;  J.N = DM;   J.K = 512; J.dst = (u16*)(ws + O_WT_CO); } \
    else if ((t) < T8) { lt = (t) - T7; J.src = p.w_fi;  J.N = 2 * DFF; J.K = DM; J.dst = (u16*)(ws + O_WT_FI); J.g = p.norm_ffn_g; J.perm = 1; } \
    else               { lt = (t) - T8; J.src = p.w_fo;  J.N = DM;   J.K = DFF; J.dst = (u16*)(ws + O_WT_FO); } \
    const int nkt_ = J.K / 64; J.kt = lt % nkt_; J.ntile = lt / nkt_; } while (0)
  {
    int t = blockIdx.x; ConvRegs R, Rn;
    if (t < T9) { ConvJob J; CONV_DECODE(t, J); conv_load(J, R, ctid); }
    while (t < T9) {
      const int tn = t + gridDim.x;
      if (tn < T9) { ConvJob Jn; CONV_DECODE(tn, Jn); conv_load(Jn, Rn, ctid); }
      { ConvJob J; CONV_DECODE(t, J); conv_store(J, R, ctid, lds); }
      R = Rn; t = tn;
    }
  }
#undef CONV_DECODE
  const int tid = otid(), lane = tid & 63, wid = tid >> 6;
  for (int r = blockIdx.x * 8 + wid; r < NMEMROWS; r += gridDim.x * 8) {
    const float* src = r < 512 ? p.mem_prompt + (long)r * DM : p.mem_sample + (long)(r - 512) * DM;
    prep_row(src, (u16*)(ws + O_MEMB) + (long)r * DM, (float*)(ws + O_MEMRS) + r, lane);
  }
  if (blockIdx.x == 0) {
    float* tab = (float*)(ws + O_BTAB);
    for (int i = tid; i < 8 * 257; i += NT_THREADS) {
      const int h = i / 257, idx = i % 257;
      tab[h * 260 + idx] = p.rel_table[t5_bucket(idx - 128) * 8 + h] * LOG2E;
    }
    if (tid < 8) { float mx = -1e30f; for (int b = 0; b < 32; ++b) mx = fmaxf(mx, p.rel_table[b * 8 + tid]); tab[tid * 260 + 257] = mx * LOG2E; }
  }
}

constexpr int QBLK = 32, KVBLK = 64, NW = 8, HD = 128;
constexpr float SCALE = 0.088388347648318440f;
constexpr float THR2 = 8.f * LOG2E;
constexpr size_t SHM_V = KVBLK * HD * 2, SHM_K = KVBLK * HD * 2;
constexpr size_t SHM_TAB = 2 * SHM_V + 2 * SHM_K + NW * 64 * 4;
#define KSWZ(row, colB) ((row) * 256 + ((colB) ^ (((row) & 7) << 4)))

template <bool BIAS>
DI void partialSM(f32x16& p0, f32x16& p1, float& m_reg, float& mn, float& alpha, float cb, bool near, const float* tab, int rel0, int hi) {
  constexpr float C = SCALE * LOG2E;
  float pmax;
  if (BIAS && near) {
#pragma unroll
    for (int c4 = 0; c4 < 4; ++c4) {
#pragma unroll
      for (int rr = 0; rr < 4; ++rr) {
        const int r = c4 * 4 + rr;
        int rel = rel0 + crow(r, hi); rel = rel < -128 ? -128 : (rel > 128 ? 128 : rel);
        p0[r] = fmaf(p0[r], C, tab[rel + 128]);
        int rel1 = rel0 + 32 + crow(r, hi); rel1 = rel1 < -128 ? -128 : (rel1 > 128 ? 128 : rel1);
        p1[r] = fmaf(p1[r], C, tab[rel1 + 128]);
      }
      SBAR();
    }
    pmax = p0[0];
#pragma unroll
    for (int r = 1; r < 16; ++r) pmax = fmaxf(pmax, p0[r]);
#pragma unroll
    for (int r = 0; r < 16; ++r) pmax = fmaxf(pmax, p1[r]);
  } else {
    pmax = p0[0];
#pragma unroll
    for (int r = 1; r < 16; ++r) pmax = fmaxf(pmax, p0[r]);
#pragma unroll
    for (int r = 0; r < 16; ++r) pmax = fmaxf(pmax, p1[r]);
    pmax = fmaf(pmax, C, cb);
  }
  { auto rr = __builtin_amdgcn_permlane32_swap(__float_as_uint(pmax), __float_as_uint(pmax), false, false);
    pmax = fmaxf(__uint_as_float(rr[0]), __uint_as_float(rr[1])); }
  if (__builtin_expect(__all(pmax - m_reg <= THR2), 1)) { mn = m_reg; alpha = 1.f; }
  else { mn = fmaxf(m_reg, pmax); alpha = __builtin_amdgcn_exp2f(m_reg - mn); m_reg = mn; }
  if (BIAS && near) {
#pragma unroll
    for (int r = 0; r < 16; ++r) { p0[r] -= mn; p1[r] -= mn; }
  } else {
    const float off = cb - mn;
#pragma unroll
    for (int r = 0; r < 16; ++r) { p0[r] = fmaf(p0[r], C, off); p1[r] = fmaf(p1[r], C, off); }
  }
#pragma unroll
  for (int r = 0; r < 16; ++r) p0[r] = __builtin_amdgcn_exp2f(p0[r]);
}
DI void finishSM(f32x16& p0, f32x16& p1, float alpha, float& l_reg, bf16x8& pa0, bf16x8& pa1, bf16x8& pa2, bf16x8& pa3) {
#pragma unroll
  for (int r = 0; r < 16; ++r) p1[r] = __builtin_amdgcn_exp2f(p1[r]);
  float ps = 0;
#pragma unroll
  for (int r = 0; r < 16; ++r) ps += p0[r];
#pragma unroll
  for (int r = 0; r < 16; ++r) ps += p1[r];
  { auto rr = __builtin_amdgcn_permlane32_swap(__float_as_uint(ps), __float_as_uint(ps), false, false);
    ps = __uint_as_float(rr[0]) + __uint_as_float(rr[1]); }
  l_reg = l_reg * alpha + ps;
#define PK4(P, BASE, OUT) do { unsigned a0 = cvtpk(P[BASE + 0], P[BASE + 1]), a1 = cvtpk(P[BASE + 2], P[BASE + 3]);   \
    unsigned b0 = cvtpk(P[BASE + 4], P[BASE + 5]), b1 = cvtpk(P[BASE + 6], P[BASE + 7]);                              \
    auto r0 = __builtin_amdgcn_permlane32_swap(a0, b0, false, false); auto r1 = __builtin_amdgcn_permlane32_swap(a1, b1, false, false); \
    u32x4 w = {r0[0], r1[0], r0[1], r1[1]}; OUT = *reinterpret_cast<bf16x8*>(&w); } while (0)
  PK4(p0, 0, pa0); PK4(p0, 8, pa1); PK4(p1, 0, pa2); PK4(p1, 8, pa3);
#undef PK4
}
DI void qkt(f32x16& p0, f32x16& p1, const char* Ks, const bf16x8* qr, int r32, int hi) {
  p0 = f32x16{}; p1 = f32x16{};
#pragma unroll
  for (int d0 = 0; d0 < 8; ++d0) { int cb = (d0 * 16 + hi * 8) * 2;
    bf16x8 b0 = *reinterpret_cast<const bf16x8*>(Ks + KSWZ(r32, cb));
    bf16x8 b1 = *reinterpret_cast<const bf16x8*>(Ks + KSWZ(32 + r32, cb));
    p0 = __builtin_amdgcn_mfma_f32_32x32x16_bf16(b0, qr[d0], p0, 0, 0, 0);
    p1 = __builtin_amdgcn_mfma_f32_32x32x16_bf16(b1, qr[d0], p1, 0, 0, 0); }
}
DI int v_st(int k, int c) { const int kk = (k & ~0xC) | ((k & 4) << 1) | ((k & 8) >> 1); return ((kk >> 3) * 4 + (c >> 5)) * 512 + ((kk & 7) * 32 + (c & 31)) * 2; }
DI int v_rd_base(int lane) { return ((lane & 3) << 3) | (((lane >> 2) & 3) << 6) | (((lane >> 4) & 1) << 5) | (((lane >> 5) & 1) << 8); }
constexpr int v_rd_off(int d0, int ks, int half) { return d0 * 512 + ks * 4096 + half * 2048; }
template <int OFF> DI s16x4 tr_read(int vb) {
  s16x4 r; asm volatile("ds_read_b64_tr_b16 %0, %1 offset:%2" : "=&v"(r) : "v"(vb), "i"(OFF) : "memory"); return r;
}
template <int D0> DI void pv_one(f32x16& od, int vb, bf16x8 pa0, bf16x8 pa1, bf16x8 pa2, bf16x8 pa3) {
  const s16x4 l0 = tr_read<v_rd_off(D0, 0, 0)>(vb), h0 = tr_read<v_rd_off(D0, 0, 1)>(vb), l1 = tr_read<v_rd_off(D0, 1, 0)>(vb), h1 = tr_read<v_rd_off(D0, 1, 1)>(vb);
  const s16x4 l2 = tr_read<v_rd_off(D0, 2, 0)>(vb), h2 = tr_read<v_rd_off(D0, 2, 1)>(vb), l3 = tr_read<v_rd_off(D0, 3, 0)>(vb), h3 = tr_read<v_rd_off(D0, 3, 1)>(vb);
  asm volatile("s_waitcnt lgkmcnt(0)" ::: "memory"); SBAR();
#define PK(L, H) (bf16x8){L[0], L[1], L[2], L[3], H[0], H[1], H[2], H[3]}
  od = __builtin_amdgcn_mfma_f32_32x32x16_bf16(pa0, PK(l0, h0), od, 0, 0, 0);
  od = __builtin_amdgcn_mfma_f32_32x32x16_bf16(pa1, PK(l1, h1), od, 0, 0, 0);
  od = __builtin_amdgcn_mfma_f32_32x32x16_bf16(pa2, PK(l2, h2), od, 0, 0, 0);
  od = __builtin_amdgcn_mfma_f32_32x32x16_bf16(pa3, PK(l3, h3), od, 0, 0, 0);
#undef PK
}
DI void pv_d0(f32x16* o, int vb, bf16x8 pa0, bf16x8 pa1, bf16x8 pa2, bf16x8 pa3) {
  pv_one<0>(o[0], vb, pa0, pa1, pa2, pa3); pv_one<1>(o[1], vb, pa0, pa1, pa2, pa3); pv_one<2>(o[2], vb, pa0, pa1, pa2, pa3); pv_one<3>(o[3], vb, pa0, pa1, pa2, pa3);
}

template <int LDQ, int LDK, int LDO, bool BIAS>
DI void attn_body(const u16* __restrict__ Qb, const u16* __restrict__ Kh, const u16* __restrict__ Vh, u16* __restrict__ Ob, int seq, int q0, char* lds) {
  const int tid = otid(), wid = tid >> 6, lane = tid & 63, r32 = lane & 31, hi = lane >> 5;
  char* V_lds = lds; char* K_lds = lds + 2 * SHM_V;
  float* ws = (float*)(lds + 2 * SHM_V + 2 * SHM_K) + wid * 64; float* li_l = ws; float* al_l = ws + 32;
  const float* tab = (const float*)(lds + SHM_TAB);
  float m_reg = -1e30f, l_reg = 0; f32x16 o[4] = {}; bf16x8 qr[8];
  const u16* Qw = Qb + (long)(wid * QBLK + r32) * LDQ + hi * 8;
#pragma unroll
  for (int d0 = 0; d0 < 8; ++d0) qr[d0] = ld8(Qw + d0 * 16);
  const int sr = tid >> 4, sc = (tid & 15) * 8, vst0 = v_st(sr, sc), vst1 = v_st(32 + sr, sc);
  const int vb0 = (int)(uintptr_t)V_lds + v_rd_base(lane);
  constexpr int SDEPTH = BIAS ? 1 : 2;
  struct { bf16x8 vs0, vs1, ks0, ks1; } sr_[SDEPTH];
  const int qpos = q0 + wid * QBLK + r32;
  float biasL = 0.f, biasR = 0.f;
#define SLOAD(i, k0) do { sr_[i].vs0 = ld8(&Vh[(long)((k0) + sr) * LDK + sc]); sr_[i].vs1 = ld8(&Vh[(long)((k0) + 32 + sr) * LDK + sc]); \
    sr_[i].ks0 = ld8(&Kh[(long)((k0) + sr) * LDK + sc]); sr_[i].ks1 = ld8(&Kh[(long)((k0) + 32 + sr) * LDK + sc]); } while (0)
#define SWRITE(b, i) do { *(bf16x8*)(V_lds + (b) * SHM_V + vst0) = sr_[i].vs0;          \
    *(bf16x8*)(V_lds + (b) * SHM_V + vst1) = sr_[i].vs1; int kc = sc * 2;               \
    *(bf16x8*)(K_lds + (b) * SHM_K + KSWZ(sr, kc)) = sr_[i].ks0;                       \
    *(bf16x8*)(K_lds + (b) * SHM_K + KSWZ(32 + sr, kc)) = sr_[i].ks1; } while (0)
#define SWAIT() do { if constexpr (SDEPTH == 2) asm volatile("s_waitcnt vmcnt(4)" ::: "memory"); else asm volatile("s_waitcnt vmcnt(0)" ::: "memory"); } while (0)
#define RESC(a) do { if (__any((a) < 1.f)) { if (hi == 0) al_l[r32] = (a); asm volatile("s_waitcnt lgkmcnt(0)" ::: "memory"); \
    _Pragma("unroll") for (int d = 0; d < 4; ++d) _Pragma("unroll") for (int r = 0; r < 16; ++r) o[d][r] *= al_l[crow(r, hi)]; } } while (0)
#define TILE_NEAR(tk) (BIAS && ((tk) * KVBLK + 63 >= q0 - 128) && ((tk) * KVBLK <= q0 + 255 + 128))
#define TILE_CB(tk) (BIAS ? (((tk) * KVBLK > q0) ? biasR : biasL) : 0.f)
#define PSM(P0, P1, MN, AL, tk) partialSM<BIAS>(P0, P1, m_reg, MN, AL, TILE_CB(tk), TILE_NEAR(tk), tab, (tk) * KVBLK - qpos, hi)
  f32x16 pA0, pA1, pB0, pB1; float mnA, mnB, alA, alB; bf16x8 pa0, pa1, pa2, pa3; const int NT = seq / KVBLK;
  constexpr int SE = 0, SO = SDEPTH - 1;
  SLOAD(SE, 0); asm volatile("s_waitcnt vmcnt(0)" ::: "memory"); SWRITE(0, SE); __syncthreads();
  if (BIAS) { biasL = __uint_as_float(__builtin_amdgcn_readfirstlane(__float_as_uint(tab[0]))); biasR = __uint_as_float(__builtin_amdgcn_readfirstlane(__float_as_uint(tab[256]))); }
  qkt(pA0, pA1, K_lds, qr, r32, hi); PSM(pA0, pA1, mnA, alA, 0);
  SLOAD(SO, KVBLK); if constexpr (SDEPTH == 2) { if (2 < NT) SLOAD(SE, 2 * KVBLK); }
  SWAIT(); SWRITE(1, SO); __syncthreads();
  for (int j = 1; j + 1 < NT; j += 2) {
    SBAR(); qkt(pB0, pB1, K_lds + SHM_K, qr, r32, hi);
    finishSM(pA0, pA1, alA, l_reg, pa0, pa1, pa2, pa3); SBAR();
    SLOAD(SO, (j + SDEPTH) * KVBLK); SBAR();
    pv_d0(o, vb0, pa0, pa1, pa2, pa3); PSM(pB0, pB1, mnB, alB, j);
    __syncthreads(); SWAIT(); SWRITE(0, SE);
    RESC(alB); __syncthreads();
    SBAR(); qkt(pA0, pA1, K_lds, qr, r32, hi);
    finishSM(pB0, pB1, alB, l_reg, pa0, pa1, pa2, pa3); SBAR();
    if (SDEPTH == 1 || j + 3 < NT) SLOAD(SE, (j + 1 + SDEPTH) * KVBLK); SBAR();
    pv_d0(o, vb0 + (int)SHM_V, pa0, pa1, pa2, pa3); PSM(pA0, pA1, mnA, alA, j + 1);
    __syncthreads(); SWAIT(); SWRITE(1, SO);
    RESC(alA); __syncthreads();
  }
  SBAR(); qkt(pB0, pB1, K_lds + SHM_K, qr, r32, hi);
  finishSM(pA0, pA1, alA, l_reg, pa0, pa1, pa2, pa3); SBAR();
  pv_d0(o, vb0, pa0, pa1, pa2, pa3); PSM(pB0, pB1, mnB, alB, NT - 1);
  __syncthreads(); RESC(alB);
  finishSM(pB0, pB1, alB, l_reg, pa0, pa1, pa2, pa3); SBAR();
  pv_d0(o, vb0 + (int)SHM_V, pa0, pa1, pa2, pa3);
  if (hi == 0) li_l[r32] = l_reg; asm volatile("s_waitcnt lgkmcnt(0)" ::: "memory");
  float rli[16];
#pragma unroll
  for (int r = 0; r < 16; ++r) rli[r] = __builtin_amdgcn_rcpf(li_l[crow(r, hi)]);
  u16* Ow = Ob + (long)(wid * QBLK) * LDO;
#pragma unroll
  for (int r = 0; r < 16; ++r) { int orow = crow(r, hi);
#pragma unroll
    for (int d0 = 0; d0 < 4; ++d0) Ow[(long)orow * LDO + d0 * 32 + r32] = f2bf(o[d0][r] * rli[r]); }
#undef SLOAD
#undef SWRITE
#undef SWAIT
#undef RESC
#undef TILE_NEAR
#undef TILE_CB
#undef PSM
}

constexpr int DA_V = 0, DA_K = 65536, DA_P = 98304, DA_L = 131072, DA_TAB = 132096;
template <int PROBE, int MODE>
DI void dattn_body(const u16* __restrict__ Qb, const u16* __restrict__ Kh, const u16* __restrict__ Vh, u16* __restrict__ Ob, const u16* __restrict__ O1, float lam, const float* __restrict__ subg, int seq, int q0, float kmax2, char* lds) {
  const int tid = otid(), wid = tid >> 6, lane = tid & 63, r32 = lane & 31, hi = lane >> 5, rg = wid >> 1, kh = wid & 1;
  char* V_lds = lds + DA_V; char* K_lds = lds + DA_K; char* P_lds = lds + DA_P; float* lsum = (float*)(lds + DA_L); const float* tab = (const float*)(lds + DA_TAB);
  constexpr float C = SCALE * LOG2E;
  bf16x8 qr[8];
  const u16* Qw = Qb + (long)(rg * 32 + r32) * DM + hi * 8;
#pragma unroll
  for (int d0 = 0; d0 < 8; ++d0) qr[d0] = ld8(Qw + d0 * 16);
  float q2 = 0.f;
#pragma unroll
  for (int d0 = 0; d0 < 8; ++d0)
#pragma unroll
    for (int e = 0; e < 8; ++e) { const float f = bf2f((u16)qr[d0][e]); q2 = fmaf(f, f, q2); }
  { auto rr = __builtin_amdgcn_permlane32_swap(__float_as_uint(q2), __float_as_uint(q2), false, false); q2 = __uint_as_float(rr[0]) + __uint_as_float(rr[1]); }
  const int sr = tid >> 4, sc = (tid & 15) * 8, vst0 = v_st(sr, sc), vst1 = v_st(32 + sr, sc), kst0 = KSWZ(sr, sc * 2), kst1 = KSWZ(32 + sr, sc * 2);
  const int vb0 = (int)(uintptr_t)V_lds + kh * 16384 + v_rd_base(lane);
  const int qpos = q0 + rg * 32 + r32;
  char* pw = P_lds + wid * 2048 + lane * 32;
  const char* pr = P_lds + (wid ^ 1) * 2048 + lane * 32;
  const int wu = __builtin_amdgcn_readfirstlane(wid);
  unsigned koff[2], voff[2];
#pragma unroll
  for (int i = 0; i < 2; ++i) {
    const int a = i * 8192 + wid * 1024 + lane * 16;
    { const int row = a >> 8, pch = (a & 255) >> 4, c = pch ^ (row & 7); koff[i] = (unsigned)(row * DM + c * 8) * 2u; }
    { const int q = a >> 4, sub = q >> 5, kk = (sub >> 2) * 8 + ((q & 31) >> 2), k = (kk & ~0xC) | ((kk & 4) << 1) | ((kk & 8) >> 1), col = (sub & 3) * 32 + (q & 3) * 8;
      voff[i] = (unsigned)(k * DM + col) * 2u; }
  }
#define DMA16(gp, lp) __builtin_amdgcn_global_load_lds((const unsigned*)(gp), (PG8_LAS unsigned*)(lp), 16, 0, 0)
#define KDMA(k0, b) do { const char* g_ = (const char*)(Kh + (long)(k0) * DM); char* l_ = K_lds + (b) * 16384 + wu * 1024; \
    DMA16(g_ + koff[0], l_); DMA16(g_ + koff[1], l_ + 8192); } while (0)
#define VDMA(k0, b) do { const char* g_ = (const char*)(Vh + (long)(k0) * DM); char* l_ = V_lds + (b) * 32768 + wu * 1024; \
    DMA16(g_ + voff[0], l_); DMA16(g_ + voff[1], l_ + 8192); DMA16(g_ + voff[0] + 256, l_ + 16384); DMA16(g_ + voff[1] + 256, l_ + 16384 + 8192); } while (0)
#define DMAWAIT() asm volatile("s_waitcnt vmcnt(0)" ::: "memory")
#define QKH(b) do { S = f32x16{}; const char* Ks_ = K_lds + (b) * 16384; _Pragma("unroll") for (int d0 = 0; d0 < 8; ++d0) { \
    const bf16x8 kf = *reinterpret_cast<const bf16x8*>(Ks_ + KSWZ(32 * kh + r32, (d0 * 16 + hi * 8) * 2)); \
    S = __builtin_amdgcn_mfma_f32_32x32x16_bf16(kf, qr[d0], S, 0, 0, 0); } } while (0)
#define PK4S(BASE, OUT) do { unsigned a0 = cvtpk(S[BASE + 0], S[BASE + 1]), a1 = cvtpk(S[BASE + 2], S[BASE + 3]);   \
    unsigned b0 = cvtpk(S[BASE + 4], S[BASE + 5]), b1 = cvtpk(S[BASE + 6], S[BASE + 7]);                              \
    auto r0 = __builtin_amdgcn_permlane32_swap(a0, b0, false, false); auto r1 = __builtin_amdgcn_permlane32_swap(a1, b1, false, false); \
    u32x4 w = {r0[0], r1[0], r0[1], r1[1]}; OUT = *reinterpret_cast<bf16x8*>(&w); } while (0)
#define SMX_CH(c4) do { if (near_) { _Pragma("unroll") for (int rr = 0; rr < 4; ++rr) { const int r = (c4) * 4 + rr; \
        int rel = rel0_ + crow(r, hi); rel = rel < -128 ? -128 : (rel > 128 ? 128 : rel); S[r] = fmaf(S[r], C, tab[rel + 128] - Mrow); } } \
    else { _Pragma("unroll") for (int rr = 0; rr < 4; ++rr) { const int r = (c4) * 4 + rr; S[r] = fmaf(S[r], C, off_); } } \
    _Pragma("unroll") for (int rr = 0; rr < 4; ++rr) { const int r = (c4) * 4 + rr; S[r] = __builtin_amdgcn_exp2f(S[r]); } } while (0)
#define SMX_SETUP(tk) const int k0_ = (tk) * KVBLK; const bool near_ = (k0_ + 63 >= q0 - 128) && (k0_ <= q0 + 127 + 128); \
    const int rel0_ = k0_ + 32 * kh - qpos; const float off_ = ((k0_ > q0) ? biasR : biasL) - Mrow;
#define SMX_FIN(pbuf) do { _Pragma("unroll") for (int r = 0; r < 16; ++r) l_reg += S[r]; \
    PK4S(0, po0); PK4S(8, po1); \
    *(bf16x8*)(pw + (pbuf) * 16384) = po0; *(bf16x8*)(pw + (pbuf) * 16384 + 16) = po1; } while (0)
#define VRD(D0, X) do { X##0 = tr_read<v_rd_off(D0, 0, 0)>(vb); X##1 = tr_read<v_rd_off(D0, 0, 1)>(vb); X##2 = tr_read<v_rd_off(D0, 1, 0)>(vb); X##3 = tr_read<v_rd_off(D0, 1, 1)>(vb); \
    X##4 = tr_read<v_rd_off(D0, 2, 0)>(vb); X##5 = tr_read<v_rd_off(D0, 2, 1)>(vb); X##6 = tr_read<v_rd_off(D0, 3, 0)>(vb); X##7 = tr_read<v_rd_off(D0, 3, 1)>(vb); } while (0)
#define VPK(L, H) (bf16x8){L[0], L[1], L[2], L[3], H[0], H[1], H[2], H[3]}
#define VMM(D0, X) do { o[D0] = __builtin_amdgcn_mfma_f32_32x32x16_bf16(A0, VPK(X##0, X##1), o[D0], 0, 0, 0); o[D0] = __builtin_amdgcn_mfma_f32_32x32x16_bf16(A1, VPK(X##2, X##3), o[D0], 0, 0, 0); \
    o[D0] = __builtin_amdgcn_mfma_f32_32x32x16_bf16(A2, VPK(X##4, X##5), o[D0], 0, 0, 0); o[D0] = __builtin_amdgcn_mfma_f32_32x32x16_bf16(A3, VPK(X##6, X##7), o[D0], 0, 0, 0); } while (0)
#define LWAIT() do { asm volatile("s_waitcnt lgkmcnt(0)" ::: "memory"); SBAR(); } while (0)
  f32x16 o[4] = {}; f32x16 S; float l_reg = 0.f; bf16x8 po0, po1; const int NT = seq / KVBLK;
  KDMA(0, 0); VDMA(0, 0); KDMA(KVBLK, 1);
  DMAWAIT();
  __syncthreads();
  const float biasL = __uint_as_float(__builtin_amdgcn_readfirstlane(__float_as_uint(tab[0]))), biasR = __uint_as_float(__builtin_amdgcn_readfirstlane(__float_as_uint(tab[256])));
  const float Mrow = C * __builtin_sqrtf(q2 * kmax2) + tab[257];
  QKH(0);
  { SMX_SETUP(0) SMX_CH(0); SMX_CH(1); SMX_CH(2); SMX_CH(3); SMX_FIN(0); }
  __syncthreads();
  for (int j = 0; j < NT; ++j) {
    const bool more = j + 1 < NT;
    if (!(PROBE & 1)) {
      if (j + 2 < NT) KDMA((j + 2) * KVBLK, j & 1);
      if (more) VDMA((j + 1) * KVBLK, (j + 1) & 1);
    }
    bf16x8 kf[8];
    if (more) { const char* Ks_ = K_lds + ((j + 1) & 1) * 16384;
#pragma unroll
      for (int d0 = 0; d0 < 8; ++d0) kf[d0] = *reinterpret_cast<const bf16x8*>(Ks_ + KSWZ(32 * kh + r32, (d0 * 16 + hi * 8) * 2)); }
    const bf16x8 pb0 = *(const bf16x8*)(pr + (j & 1) * 16384), pb1 = *(const bf16x8*)(pr + (j & 1) * 16384 + 16);
    const int vb = vb0 + (j & 1) * 32768;
    s16x4 va0, va1, va2, va3, va4, va5, va6, va7, vc0, vc1, vc2, vc3, vc4, vc5, vc6, vc7;
    VRD(0, va);
    if (more) { asm volatile("s_waitcnt lgkmcnt(10)" ::: "memory"); SBAR();
      if (!(PROBE & 4)) { S = f32x16{};
#pragma unroll
      for (int d0 = 0; d0 < 8; ++d0) S = __builtin_amdgcn_mfma_f32_32x32x16_bf16(kf[d0], qr[d0], S, 0, 0, 0); }
      SBAR(); }
    const bf16x8 A0 = kh ? pb0 : po0, A1 = kh ? pb1 : po1, A2 = kh ? po0 : pb0, A3 = kh ? po1 : pb1;
    SMX_SETUP(j + 1)
#define VMMP(D0, X) do { if (!(PROBE & 8)) VMM(D0, X); } while (0)
#define SMXP(c) do { if (!(PROBE & 2)) { if (more) SMX_CH(c); } } while (0)
    LWAIT(); VRD(1, vc); VMMP(0, va); SMXP(0);
    LWAIT(); VRD(2, va); VMMP(1, vc); SMXP(1);
    LWAIT(); VRD(3, vc); VMMP(2, va); SMXP(2);
    LWAIT(); VMMP(3, vc); SMXP(3);
    if (!(PROBE & 2)) { if (more) SMX_FIN((j + 1) & 1); }
    DMAWAIT();
    __syncthreads();
#undef VMMP
#undef SMXP
  }
  { auto rr = __builtin_amdgcn_permlane32_swap(__float_as_uint(l_reg), __float_as_uint(l_reg), false, false); l_reg = __uint_as_float(rr[0]) + __uint_as_float(rr[1]); }
  if (hi == 0) lsum[wid * 32 + r32] = l_reg;
  __syncthreads();
  float rli[16];
#pragma unroll
  for (int r = 0; r < 16; ++r) rli[r] = __builtin_amdgcn_rcpf(lsum[wid * 32 + crow(r, hi)] + lsum[(wid ^ 1) * 32 + crow(r, hi)]);
  u16* Ow = Ob + (long)(rg * 32) * 4096 + kh * 128;
  if (PROBE) {
    float acc_ = 0.f;
#pragma unroll
    for (int r = 0; r < 16; ++r)
#pragma unroll
      for (int d0 = 0; d0 < 4; ++d0) acc_ += o[d0][r] * rli[r];
    if (acc_ == 123.456f && seq < 0) Ow[0] = f2bf(acc_);
    return;
  }
  (void)Ow;
  {
    char* Ot = lds;
    constexpr int UOROW = 528;
#pragma unroll
    for (int r = 0; r < 16; ++r) { const int orow = rg * 32 + crow(r, hi);
#pragma unroll
      for (int d0 = 0; d0 < 4; ++d0) *reinterpret_cast<u16*>(Ot + orow * UOROW + (kh * 128 + d0 * 32 + r32) * 2) = f2bf(o[d0][r] * rli[r]); }
    __syncthreads();
    if (MODE == 0) {
#pragma unroll
      for (int it = 0; it < 8; ++it) {
        const int row = (tid >> 5) + 16 * it, c8 = (tid & 31) * 8;
        *reinterpret_cast<bf16x8*>(Ob + (long)row * DM + c8) = *reinterpret_cast<const bf16x8*>(Ot + row * UOROW + c8 * 2);
      }
    } else {
      const int c8 = (tid & 31) * 8;
      const f32x4 sg0 = *reinterpret_cast<const f32x4*>(subg + c8), sg1 = *reinterpret_cast<const f32x4*>(subg + c8 + 4);
      u32x4 a1[8];
#pragma unroll
      for (int it = 0; it < 8; ++it) a1[it] = *reinterpret_cast<const u32x4*>(O1 + (long)((tid >> 5) + 16 * it) * DM + c8);
#pragma unroll
      for (int it = 0; it < 8; ++it) {
        const int row = (tid >> 5) + 16 * it;
        const u32x4 a2 = *reinterpret_cast<const u32x4*>(Ot + row * UOROW + c8 * 2);
        f32x4 v0 = bf4lo(a1[it]) - bf4lo(a2) * lam, v1 = bf4hi(a1[it]) - bf4hi(a2) * lam;
        float ss = 0.f;
#pragma unroll
        for (int e = 0; e < 4; ++e) ss = fmaf(v0[e], v0[e], fmaf(v1[e], v1[e], ss));
        ss += __shfl_xor(ss, 1, 64); ss += __shfl_xor(ss, 2, 64); ss += __shfl_xor(ss, 4, 64); ss += __shfl_xor(ss, 8, 64); ss += __shfl_xor(ss, 16, 64);
        const float sc = rsqrtf(ss * (1.f / 256.f) + 1e-5f) * 0.8f;
        *reinterpret_cast<u32x4*>(Ob + (long)row * DM + c8) = pack8(v0 * sg0 * sc, v1 * sg1 * sc);
      }
    }
  }
#undef DMA16
#undef KDMA
#undef VDMA
#undef DMAWAIT
#undef QKH
#undef PK4S
#undef SMX_CH
#undef SMX_SETUP
#undef SMX_FIN
#undef VRD
#undef VPK
#undef VMM
#undef LWAIT
}

constexpr int GROW = 272;
constexpr int UROW = 528;
DI void gating_item(const Params& p, int tok0, int gi, char* lds) {
  char* ws = p.ws;
  const u16* U = (const u16*)(ws + O_SEG); const u16* VA = (const u16*)(ws + O_SEG + SEGSZ); u16* OA = (u16*)(ws + O_XB);
  const float* ST = (const float*)(ws + O_LNST);
  char* Ut = lds + 256 * GROW; float* bs = (float*)(Ut + 128 * UROW); float* lnl = bs + 128;
  const int tid = otid(), wid = tid >> 6, lane = tid & 63, r32 = lane & 31, hi = lane >> 5;
  bf16x8 ur[8], vr[8];
  const int j = (wid & 1) * 64 + lane;
#pragma unroll
  for (int it = 0; it < 8; ++it) ur[it] = ld8(U + (long)(tok0 + (tid >> 5) + 16 * it) * DM + gi * 256 + (tid & 31) * 8);
#pragma unroll
  for (int it = 0; it < 8; ++it) vr[it] = ld8(VA + (long)(tok0 + j) * DM + gi * 256 + ((wid >> 1) + 4 * it) * 8);
  const float lnv = tid < 256 ? p.ln_v_g[gi * 256 + tid] : p.ln_v_b[gi * 256 + tid - 256];
  const float bsv = p.b_spatial[gi * 128 + (tid & 127)];
  const float mean = ST[2 * (tok0 + j)] * (1.f / 2048.f), rs = rsqrtf(fmaxf(ST[2 * (tok0 + j) + 1] * (1.f / 2048.f) - mean * mean, 0.f) + 1e-6f);
  SBAR();
#pragma unroll
  for (int it = 0; it < 8; ++it) *reinterpret_cast<bf16x8*>(Ut + ((tid >> 5) + 16 * it) * UROW + (tid & 31) * 16) = ur[it];
  lnl[tid] = lnv;
  if (tid < 128) bs[tid] = bsv;
  __syncthreads();
#pragma unroll
  for (int it = 0; it < 8; ++it) {
    const int d8 = ((wid >> 1) + 4 * it) * 8;
    const f32x4 g0 = *reinterpret_cast<const f32x4*>(lnl + d8), g1 = *reinterpret_cast<const f32x4*>(lnl + d8 + 4);
    const f32x4 b0 = *reinterpret_cast<const f32x4*>(lnl + 256 + d8), b1 = *reinterpret_cast<const f32x4*>(lnl + 256 + d8 + 4);
#pragma unroll
    for (int e = 0; e < 8; ++e) {
      const float y = (bf2f((u16)vr[it][e]) - mean) * rs * (e < 4 ? g0[e & 3] : g1[e & 3]) + (e < 4 ? b0[e & 3] : b1[e & 3]);
      *reinterpret_cast<u16*>(lds + (d8 + e) * GROW + j * 2) = f2bf(y);
    }
  }
  __syncthreads();
  f32x16 acc[4] = {};
  const float* W = p.w_spatial + (long)gi * 128 * 128;
#pragma unroll
  for (int kq = 0; kq < 2; ++kq) {
    f32x4 wv[4][4][2];
#pragma unroll
    for (int k2 = 0; k2 < 4; ++k2)
#pragma unroll
      for (int mi = 0; mi < 4; ++mi) {
        const float* wp = W + (mi * 32 + r32) * 128 + (kq * 4 + k2) * 16 + hi * 8;
        wv[k2][mi][0] = *reinterpret_cast<const f32x4*>(wp); wv[k2][mi][1] = *reinterpret_cast<const f32x4*>(wp + 4);
      }
    SBAR();
#pragma unroll
    for (int k2 = 0; k2 < 4; ++k2) {
      const int ks = kq * 4 + k2;
      const bf16x8 b = *reinterpret_cast<const bf16x8*>(lds + (32 * wid + r32) * GROW + ks * 32 + hi * 16);
#pragma unroll
      for (int mi = 0; mi < 4; ++mi) {
        const f32x4 w0 = wv[k2][mi][0], w1 = wv[k2][mi][1];
        u32x4 aw = {cvtpk(w0[0], w0[1]), cvtpk(w0[2], w0[3]), cvtpk(w1[0], w1[1]), cvtpk(w1[2], w1[3])};
        acc[mi] = __builtin_amdgcn_mfma_f32_32x32x16_bf16(*reinterpret_cast<bf16x8*>(&aw), b, acc[mi], 0, 0, 0);
      }
    }
    SBAR();
  }
#pragma unroll
  for (int mi = 0; mi < 4; ++mi)
#pragma unroll
    for (int i = 0; i < 16; ++i) {
      const int ii = mi * 32 + crow(i, hi);
      u16* up = reinterpret_cast<u16*>(Ut + ii * UROW + (32 * wid + r32) * 2);
      *up = f2bf(bf2f(*up) * (acc[mi][i] + bs[ii]));
    }
  __syncthreads();
  bf16x8 orr[8];
#pragma unroll
  for (int it = 0; it < 8; ++it) orr[it] = *reinterpret_cast<const bf16x8*>(Ut + ((tid >> 5) + 16 * it) * UROW + (tid & 31) * 16);
#pragma unroll
  for (int it = 0; it < 8; ++it) *reinterpret_cast<bf16x8*>(OA + (long)(tok0 + (tid >> 5) + 16 * it) * DM + gi * 256 + (tid & 31) * 8) = orr[it];
  __syncthreads();
}

DI const float* group_x(const Params& p, int g) { return g < 2 ? p.x_prompt + (long)g * GT * DM : p.x_sample + (long)(g - 2) * GT * DM; }

DI void run_phase(const Params& p, int ph, char* lds, int sel = 0) {
  char* ws = p.ws;
  const int tid = otid(), lane = tid & 63, wid = tid >> 6;
  if (ph == 0) { if (PH_MASK & 0x4000) phase_convert(p, lds); return; }
  if (ph == 1) { if (!(PH_MASK & 0x8000)) return;
    EpiScaleBf16 E{(u16*)(ws + O_MEMKV), 1024, (const float*)(ws + O_MEMRS), nullptr};
    run_gemm(lds, (const u16*)(ws + O_MEMB), (const u16*)(ws + O_WT_CKV), NMEMROWS, 1024, DM, E);
    return;
  }
  constexpr int kSeq[11] = {0, 1, 2, 4, 5, 7, 8, 9, 11, 12, 13};
  const int g = (ph - 2) / 11, kq = (ph - 2) % 11;
  int sp = 0;
#pragma unroll
  for (int q = 0; q < 11; ++q) sp = (kq == q) ? kSeq[q] : sp;
  float* xout = p.out + (long)g * GT * DM;
  u16* XB = (u16*)(ws + O_XB); float* RSTD = (float*)(ws + O_RSTD);
  u16* SEG = (u16*)(ws + O_SEG);
  const long SEGE = (long)GT * DM;
  if (!((PH_MASK >> sp) & 1)) return;
  switch (sp) {
    case 0: case 6: case 10: {
      const float* src = sp == 0 ? group_x(p, g) : xout;
      {
        const int step = gridDim.x * 8;
        int r = blockIdx.x * 8 + wid;
        for (; r + step < GT; r += 2 * step) {
          const float* sa = src + (long)r * DM; const float* sb = src + (long)(r + step) * DM;
          f32x4 va[8], vb[8]; float ssa = 0.f, ssb = 0.f;
#pragma unroll
          for (int i = 0; i < 8; ++i) { va[i] = *reinterpret_cast<const f32x4*>(sa + lane * 4 + 256 * i); vb[i] = *reinterpret_cast<const f32x4*>(sb + lane * 4 + 256 * i); }
#pragma unroll
          for (int i = 0; i < 8; ++i) { ssa += va[i][0] * va[i][0] + va[i][1] * va[i][1] + va[i][2] * va[i][2] + va[i][3] * va[i][3]; ssb += vb[i][0] * vb[i][0] + vb[i][1] * vb[i][1] + vb[i][2] * vb[i][2] + vb[i][3] * vb[i][3]; }
          ssa = wave_sum(ssa); ssb = wave_sum(ssb);
          const float ra = rsqrtf(ssa * (1.f / 2048.f) + 1e-6f), rb = rsqrtf(ssb * (1.f / 2048.f) + 1e-6f);
#pragma unroll
          for (int i = 0; i < 8; ++i) { u32x2 wa = {cvtpk(va[i][0] * ra, va[i][1] * ra), cvtpk(va[i][2] * ra, va[i][3] * ra)}; *reinterpret_cast<u32x2*>(XB + (long)r * DM + lane * 4 + 256 * i) = wa;
            u32x2 wb = {cvtpk(vb[i][0] * rb, vb[i][1] * rb), cvtpk(vb[i][2] * rb, vb[i][3] * rb)}; *reinterpret_cast<u32x2*>(XB + (long)(r + step) * DM + lane * 4 + 256 * i) = wb; }
        }
        for (; r < GT; r += step) {
          const float* sa = src + (long)r * DM; f32x4 va[8]; float ssa = 0.f;
#pragma unroll
          for (int i = 0; i < 8; ++i) { va[i] = *reinterpret_cast<const f32x4*>(sa + lane * 4 + 256 * i); ssa += va[i][0] * va[i][0] + va[i][1] * va[i][1] + va[i][2] * va[i][2] + va[i][3] * va[i][3]; }
          ssa = wave_sum(ssa); const float ra = rsqrtf(ssa * (1.f / 2048.f) + 1e-6f);
#pragma unroll
          for (int i = 0; i < 8; ++i) { u32x2 wa = {cvtpk(va[i][0] * ra, va[i][1] * ra), cvtpk(va[i][2] * ra, va[i][3] * ra)}; *reinterpret_cast<u32x2*>(XB + (long)r * DM + lane * 4 + 256 * i) = wa; }
        }
      }
      if (sp == 0 && blockIdx.x == 0 && tid < 32) ((float*)(ws + O_BTAB + 12288))[tid] = 0.f;
      if (sp == 0) { float* z = (float*)(ws + O_LNST); for (int i = blockIdx.x * NT_THREADS + tid; i < 4 * GT; i += gridDim.x * NT_THREADS) z[i] = 0.f; }
    } break;
    case 14: {
      const int nseq = g < 2 ? 1 : 2, slen = GT / nseq;
      const u16* Kp = SEG + 3 * SEGE; unsigned* kmax = (unsigned*)(ws + O_BTAB + 12288);
      {
        const u16* VAp = SEG + SEGE; float* ST = (float*)(ws + O_LNST);
#pragma unroll 2
        for (int r = blockIdx.x * 8 + wid; r < GT; r += gridDim.x * 8) {
          float s1 = 0.f, s2 = 0.f;
#pragma unroll
          for (int i = 0; i < 4; ++i) { const bf16x8 v = ld8(VAp + (long)r * DM + lane * 8 + 512 * i);
#pragma unroll
            for (int e = 0; e < 8; ++e) { const float f = bf2f((u16)v[e]); s1 += f; s2 = fmaf(f, f, s2); } }
          s1 = wave_sum(s1); s2 = wave_sum(s2);
          if (lane == 0) { const float mean = s1 * (1.f / 2048.f); const float var = fmaxf(s2 * (1.f / 2048.f) - mean * mean, 0.f); ST[2 * r] = mean; ST[2 * r + 1] = rsqrtf(var + 1e-6f); }
        }
      }
      for (int sq = 0; sq < nseq; ++sq) {
        float mx[4] = {0.f, 0.f, 0.f, 0.f};
        for (int r = sq * slen + blockIdx.x * 8 + wid; r < (sq + 1) * slen; r += gridDim.x * 8) {
#pragma unroll
          for (int i = 0; i < 4; ++i) {
            const bf16x8 v = ld8(Kp + (long)r * DM + lane * 8 + 512 * i);
            float ss = 0.f;
#pragma unroll
            for (int e = 0; e < 8; ++e) { const float f = bf2f((u16)v[e]); ss = fmaf(f, f, ss); }
            ss += __shfl_xor(ss, 1, 64); ss += __shfl_xor(ss, 2, 64); ss += __shfl_xor(ss, 4, 64); ss += __shfl_xor(ss, 8, 64);
            mx[i] = fmaxf(mx[i], ss);
          }
        }
        if ((lane & 15) == 0) {
#pragma unroll
          for (int i = 0; i < 4; ++i) atomicMax(kmax + sq * 16 + (lane >> 4) + 4 * i, __float_as_uint(mx[i]));
        }
      }
    } break;
    case 1: {
      EpiInproj E{SEG, RSTD, (float*)(ws + O_LNST), (unsigned*)(ws + O_BTAB + 12288), g < 2 ? GT : GT / 2};
      run_gemm(lds, XB, (const u16*)(ws + O_WT_IN), GT, NIN, DM, E);
    } break;
    case 2: {
      const int nseq = g < 2 ? 1 : 2, slen = GT / nseq, nqb = slen / 128;
      const u16* Q = SEG + 2 * SEGE; const u16* Kp = SEG + 3 * SEGE; const u16* Vp = SEG + 4 * SEGE; u16* OP = (u16*)(ws + O_OP);
      const float* gtab = (const float*)(ws + O_BTAB); const float* kmax = (const float*)(ws + O_BTAB + 12288);
      float lam;
      { float s1 = p.lq1[lane] * p.lk1[lane] + p.lq1[lane + 64] * p.lk1[lane + 64];
        float s2 = p.lq2[lane] * p.lk2[lane] + p.lq2[lane + 64] * p.lk2[lane + 64];
        s1 = wave_sum(s1); s2 = wave_sum(s2); lam = expf(s1) - expf(s2) + 0.2f; }
      u16* O1s = OP; u16* OBn = (u16*)(ws + O_OP + SEGSZ);
      for (int it = blockIdx.x; it < 1024 && sel != 2; it += gridDim.x) {
        const int qb = it % nqb; const int r = it / nqb; const int h = r & 7, sq = r >> 3;
        __syncthreads();
        if (tid < 258) ((float*)(lds + DA_TAB))[tid] = gtab[h * 260 + tid];
        const long t0 = (long)sq * slen, tq = t0 + qb * 128;
        dattn_body<0, 0>(Q + tq * DM + h * 256, Kp + t0 * DM + h * 256, Vp + t0 * DM + h * 256,
                         O1s + tq * DM + h * 256, nullptr, lam, p.subln_g, slen, qb * 128, kmax[sq * 16 + h * 2], lds);
        __syncthreads();
        dattn_body<0, 1>(Q + tq * DM + h * 256 + 128, Kp + t0 * DM + h * 256 + 128, Vp + t0 * DM + h * 256,
                         OBn + tq * DM + h * 256, O1s + tq * DM + h * 256, lam, p.subln_g, slen, qb * 128, kmax[sq * 16 + h * 2 + 1], lds);
      }
      for (int it = 2048 + blockIdx.x; it < 2048 + 1024 && sel != 1; it += gridDim.x) {
        const int gi_ = (it - 2048) & 7, c = (it - 2048) >> 3;
        __syncthreads();
        gating_item(p, c * 128, gi_, lds);
      }
    } break;
    case 3: {
      float s1 = p.lq1[lane] * p.lk1[lane] + p.lq1[lane + 64] * p.lk1[lane + 64];
      float s2 = p.lq2[lane] * p.lk2[lane] + p.lq2[lane + 64] * p.lk2[lane + 64];
      s1 = wave_sum(s1); s2 = wave_sum(s2);
      const float lam = expf(s1) - expf(s2) + 0.2f;
      const u16* OP = (const u16*)(ws + O_OP); u16* OB = SEG + SEGE;
      f32x4 sg = *reinterpret_cast<const f32x4*>(p.subln_g + lane * 4);
#pragma unroll 2
      for (int r = blockIdx.x * 8 + wid; r < GT; r += gridDim.x * 8) {
#pragma unroll
        for (int h = 0; h < 8; ++h) {
          const u16* o1 = OP + (long)r * 4096 + h * 512 + lane * 4;
          u32x2 a = *reinterpret_cast<const u32x2*>(o1), b = *reinterpret_cast<const u32x2*>(o1 + 256);
          float o0 = bflo(a[0]) - lam * bflo(b[0]), o1f = bfhi(a[0]) - lam * bfhi(b[0]), o2 = bflo(a[1]) - lam * bflo(b[1]), o3 = bfhi(a[1]) - lam * bfhi(b[1]);
          float ss = wave_sum(o0 * o0 + o1f * o1f + o2 * o2 + o3 * o3);
          const float sc = rsqrtf(ss * (1.f / 256.f) + 1e-5f) * 0.8f;
          u32x2 w = {cvtpk(o0 * sc * sg[0], o1f * sc * sg[1]), cvtpk(o2 * sc * sg[2], o3 * sc * sg[3])};
          *reinterpret_cast<u32x2*>(OB + (long)r * DM + h * 256 + lane * 4) = w;
        }
      }
    } break;
    case 4: {
      EpiMerge1 E1{xout, SEG + 5 * SEGE};
      run_gemm(lds, XB, (const u16*)(ws + O_WT_PA), GT, DM, DM, E1);
      EpiMerge2 E2{xout, SEG + 6 * SEGE, SEG};
      run_gemm(lds, (const u16*)(ws + O_OP + SEGSZ), (const u16*)(ws + O_WT_PB), GT, DM, DM, E2);
    } break;
    case 5: {
      EpiResidNorm E{group_x(p, g), sel == 3 ? (float*)(ws + O_OP) : xout, sel == 3 ? SEG + 6 * SEGE : XB, sel == 3 ? (float*)(ws + O_LNST) : (float*)(ws + O_SS2)};
      run_gemm(lds, SEG, (const u16*)(ws + O_WT_OUT), GT, DM, DM, E);
    } break;
    case 7: {
      EpiScaleBf16 E{SEG + 2 * SEGE, 512, nullptr, (const float*)(ws + O_SS2)};
      run_gemm(lds, XB, (const u16*)(ws + O_WT_CQ), GT, 512, DM, E);
    } break;
    case 8: {
      const u16* QC = SEG + 2 * SEGE; u16* OC = SEG + 3 * SEGE; const u16* MKV = (const u16*)(ws + O_MEMKV);
      for (int it = blockIdx.x; it < 256; it += gridDim.x) {
        const int h = it & 3, qb = it >> 2;
        const int tq = qb * 256;
        const int mseq = g < 2 ? g : 2 + 2 * (g - 2) + (tq >= 8192 ? 1 : 0);
        __syncthreads();
        attn_body<512, 1024, 512, false>(QC + (long)tq * 512 + h * 128, MKV + (long)mseq * 256 * 1024 + h * 128, MKV + (long)mseq * 256 * 1024 + 512 + h * 128,
                                         OC + (long)tq * 512 + h * 128, 256, 0, lds);
      }
    } break;
    case 9: {
      EpiResidNorm E{xout, sel == 3 ? (float*)(ws + O_OP) : xout, sel == 3 ? SEG + 6 * SEGE : XB, sel == 3 ? (float*)(ws + O_LNST) : (float*)(ws + O_SS3)};
      run_gemm(lds, SEG + 3 * SEGE, (const u16*)(ws + O_WT_CO), GT, DM, 512, E);
    } break;
    case 11: {
      EpiSwiglu E{SEG + 4 * SEGE, (const float*)(ws + O_SS3)};
      run_gemm(lds, XB, (const u16*)(ws + O_WT_FI), GT, 2 * DFF, DM, E);
    } break;
    case 12: {
      EpiResid E{xout, sel == 3 ? (float*)(ws + O_OP) : xout};
      run_gemm(lds, SEG + 4 * SEGE, (const u16*)(ws + O_WT_FO), GT, DM, DFF, E);
    } break;
    case 13: {
      {
        const int step = gridDim.x * 8;
        for (int r = blockIdx.x * 8 + wid; r < GT; r += 2 * step) {
          const bool two = r + step < GT;
          float* rowa = xout + (long)r * DM; float* rowb = xout + (long)(two ? r + step : r) * DM;
          float* wa_ = sel == 3 ? (float*)(ws + O_OP) + (long)r * DM : rowa; float* wb_ = sel == 3 ? (float*)(ws + O_OP) + (long)(r + step) * DM : rowb;
          f32x4 va[8], vb[8], gg[8]; float ssa = 0.f, ssb = 0.f;
#pragma unroll
          for (int i = 0; i < 8; ++i) { va[i] = *reinterpret_cast<const f32x4*>(rowa + lane * 4 + 256 * i); vb[i] = *reinterpret_cast<const f32x4*>(rowb + lane * 4 + 256 * i);
            gg[i] = *reinterpret_cast<const f32x4*>(p.norm_final_g + lane * 4 + 256 * i); }
#pragma unroll
          for (int i = 0; i < 8; ++i) { ssa += va[i][0] * va[i][0] + va[i][1] * va[i][1] + va[i][2] * va[i][2] + va[i][3] * va[i][3]; ssb += vb[i][0] * vb[i][0] + vb[i][1] * vb[i][1] + vb[i][2] * vb[i][2] + vb[i][3] * vb[i][3]; }
          ssa = wave_sum(ssa); ssb = wave_sum(ssb);
          const float ra = rsqrtf(ssa * (1.f / 2048.f) + 1e-6f), rb = rsqrtf(ssb * (1.f / 2048.f) + 1e-6f);
#pragma unroll
          for (int i = 0; i < 8; ++i) {
            *reinterpret_cast<f32x4*>(wa_ + lane * 4 + 256 * i) = va[i] * gg[i] * ra;
            if (two) *reinterpret_cast<f32x4*>(wb_ + lane * 4 + 256 * i) = vb[i] * gg[i] * rb;
          }
        }
      }
    } break;
    default: break;
  }
}

#define XB_TMO      128
#define XB_XCNT(j)  (256  + 64 * (j))
#define XB_XSUB(j)  (1280 + 64 * (j))
#define XB_XGEN(j)  (2304 + 64 * (j))
#define XB_TOP      3328
#define XB_TOPGEN   3392
#define XCD_BAR_WORDS 3456
#define XB_SPIN_CAP (1u << 18)
DI unsigned xb_ld(unsigned* p)              { return __hip_atomic_load(p, __ATOMIC_RELAXED, __HIP_MEMORY_SCOPE_AGENT); }
DI unsigned xb_add(unsigned* p, unsigned v) { return __hip_atomic_fetch_add(p, v, __ATOMIC_RELAXED, __HIP_MEMORY_SCOPE_AGENT); }
DI unsigned xb_xcc_id() { return (unsigned)__builtin_amdgcn_s_getreg((3 << 11) | 20) & 0xFu; }
#define XB_SPIN(cond, bar) do { unsigned _sp = 0; while (cond) { __builtin_amdgcn_s_sleep(1); \
    if ((++_sp & 255u) == 0u) { if (xb_ld(&(bar)[XB_TMO])) break; if (_sp > XB_SPIN_CAP) { atomicAdd(&(bar)[XB_TMO], 1u); break; } } } } while (0)
struct XcdBarrier { unsigned* bar; unsigned x; volatile PG8_LAS unsigned* st; };
DI XcdBarrier xcd_barrier_post(unsigned* bar, volatile PG8_LAS unsigned* st) {
  XcdBarrier b; b.bar = bar; b.x = xb_xcc_id(); b.st = st;
  if (threadIdx.x == 0) (void)xb_add(&bar[XB_XCNT(b.x)], 1u);
  return b;
}
DI void xcd_barrier_complete(unsigned* bar, unsigned x, unsigned& nloc, unsigned& nx) {
  const unsigned G = gridDim.x * gridDim.y * gridDim.z;
  unsigned sum, cnt, mine, sp = 0u;
  for (;;) {
    sum = 0u; cnt = 0u; mine = 0u;
#pragma unroll
    for (unsigned j = 0; j < 16; ++j) { const unsigned c = xb_ld(&bar[XB_XCNT(j)]); sum += c; cnt += (c > 0u) ? 1u : 0u; mine = (j == x) ? c : mine; }
    if (sum == G) break;
    __builtin_amdgcn_s_sleep(1);
    if ((++sp & 255u) == 0u) { if (xb_ld(&bar[XB_TMO])) break; if (sp > XB_SPIN_CAP) { atomicAdd(&bar[XB_TMO], 1u); break; } }
  }
  nloc = mine > 0u ? mine : 1u; nx = cnt > 0u ? cnt : 1u;
}
DI void xcd_barrier(const XcdBarrier& b) {
  asm volatile("s_waitcnt vmcnt(0)" ::: "memory");
  __syncthreads();
  if (threadIdx.x == 0) {
    unsigned* bar = b.bar;
    __builtin_amdgcn_s_waitcnt(0);
    unsigned nloc = b.st[0], nx = b.st[1];
    if (nloc == 0u) { xcd_barrier_complete(bar, b.x, nloc, nx); b.st[0] = nloc; b.st[1] = nx; }
    const unsigned old = xb_add(&bar[XB_XSUB(b.x)], 1u);
    const unsigned gen = old / nloc;
    if (old + 1u == (gen + 1u) * nloc) {
      __builtin_amdgcn_fence(__ATOMIC_RELEASE, "agent");
      asm volatile("s_waitcnt vmcnt(0)" ::: "memory");
      const unsigned og = xb_add(&bar[XB_TOP], 1u);
      const unsigned tg = og / nx;
      if (og + 1u == (tg + 1u) * nx) xb_add(&bar[XB_TOPGEN], 1u);
      else XB_SPIN(xb_ld(&bar[XB_TOPGEN]) == tg, bar);
      __builtin_amdgcn_fence(__ATOMIC_ACQUIRE, "agent");
      xb_add(&bar[XB_XGEN(b.x)], 1u);
      asm volatile("s_waitcnt vmcnt(0)" ::: "memory");
    } else {
      XB_SPIN(xb_ld(&bar[XB_XGEN(b.x)]) == gen, bar);
      __builtin_amdgcn_fence(__ATOMIC_ACQUIRE, "agent");
      asm volatile("s_waitcnt vmcnt(0)" ::: "memory");
    }
  }
  __syncthreads();
}

constexpr int NPHASES = 2 + 11 * NGROUP;

__global__ void __launch_bounds__(NT_THREADS) k_mega(Params p) {
  extern __shared__ __attribute__((aligned(16))) char lds[];
  __shared__ uint4 xb_words;
  cg::grid_group grid = cg::this_grid();
  if (threadIdx.x == 0) xb_words = make_uint4(0u, 0u, 0u, 0u);
  __syncthreads();
  const XcdBarrier xb = xcd_barrier_post((unsigned*)(p.ws + O_BAR), (volatile PG8_LAS unsigned*)&xb_words);
#pragma unroll 1
  for (int ph = 0; ph < NPHASES; ++ph) {
    run_phase(p, ph, lds);
    if (DUP_MASK && ph >= 2 && ((DUP_MASK >> ((ph - 2) % 11)) & 1)) { grid.sync(); run_phase(p, ph, lds, DUP_SEL); }
    if ((DUP_MASK & 0x8000) && ph == 0) { for (int rep = 0; rep < 3; ++rep) { grid.sync(); run_phase(p, ph, lds, DUP_SEL); } }
    if (ph + 1 < NPHASES) { if (ph == 0) grid.sync(); else xcd_barrier(xb); }
  }
}
#if !MEGA
__global__ void __launch_bounds__(NT_THREADS) k_phase(Params p, int ph) {
  extern __shared__ __attribute__((aligned(16))) char lds[];
  run_phase(p, ph, lds);
}
#endif

extern "C" void kernel_launch(void* const* d_in, const int* in_sizes, int n_in, void* d_out, int out_size, void* d_ws, size_t ws_size, hipStream_t stream) {
  static int grid_blocks = 0;
  if (!grid_blocks) {
    if (ws_size < O_END) { fprintf(stderr, "kernel_launch: workspace too small: %zu < %zu\n", ws_size, (size_t)O_END); return; }
    (void)hipFuncSetAttribute((const void*)k_mega, hipFuncAttributeMaxDynamicSharedMemorySize, LDS_BYTES);
#if !MEGA
    (void)hipFuncSetAttribute((const void*)k_phase, hipFuncAttributeMaxDynamicSharedMemorySize, LDS_BYTES);
#endif
    int dev = 0, cus = 0, per_cu = 0;
    (void)hipGetDevice(&dev);
    (void)hipDeviceGetAttribute(&cus, hipDeviceAttributeMultiprocessorCount, dev);
    (void)hipOccupancyMaxActiveBlocksPerMultiprocessor(&per_cu, k_mega, NT_THREADS, LDS_BYTES);
    if (per_cu < 1) per_cu = 1;
    grid_blocks = cus * per_cu;
    if (grid_blocks > 256) grid_blocks = 256;
  }
  Params p{};
  const float** pp = reinterpret_cast<const float**>(&p);
  for (int i = 0; i < 29; ++i) pp[i] = (const float*)d_in[i];
  p.out = (float*)d_out; p.ws = (char*)d_ws;
#if MEGA
  (void)hipMemsetAsync((char*)d_ws + O_BAR, 0, XCD_BAR_WORDS * 4, stream);
  void* args[] = {&p};
  hipError_t e = hipLaunchCooperativeKernel((void*)k_mega, dim3(grid_blocks), dim3(NT_THREADS), args, LDS_BYTES, stream);
  if (e != hipSuccess) fprintf(stderr, "cooperative launch failed: %s (grid %d)\n", hipGetErrorString(e), grid_blocks);
#else
  for (int ph = 0; ph < NPHASES; ++ph) hipLaunchKernelGGL(k_phase, dim3(256), dim3(NT_THREADS), LDS_BYTES, stream, p, ph);
#endif
}
```
